# Optimizing an MI355X kernel written in HIP

```python
import math
import jax, jax.numpy as jnp
from jax import lax
import numpy as np

D_MODEL = 2048
BATCH = 4
SEQ = 4096
DEPTH = 4

N_BRANCH = 3
BRANCH_WIDTH = D_MODEL // 2
S5_GROUP = 16
S5_GROUPS = BRANCH_WIDTH // S5_GROUP
S5_STATE = 64
S5_DT_MIN = 1e-3
S5_DT_MAX = 1e-1
S5_MIN_DECAY = 1e-4
GLA_HEADS = 4
GLA_DV = BRANCH_WIDTH // GLA_HEADS
GLA_DK = GLA_DV // 2
GLA_KEY = GLA_HEADS * GLA_DK
GLA_GATE_RANK = 16
GLA_GATE_TAU = 16.0
HGRN_EXPAND = 128
HGRN_HEADS = BRANCH_WIDTH // HGRN_EXPAND
HGRN_DV = BRANCH_WIDTH // HGRN_HEADS
HGRN_KEY = HGRN_HEADS * HGRN_EXPAND
CHUNK = 64
SUB_CHUNK = 16
MLP_HIDDEN = 4 * D_MODEL
DN_ALPHA = (2 * DEPTH) ** 0.25
DN_BETA = (8 * DEPTH) ** -0.25
LN_EPS = 1e-5
RMS_EPS = 1e-6

IN_WIDTHS = (BRANCH_WIDTH,
             GLA_KEY, GLA_KEY, BRANCH_WIDTH, GLA_GATE_RANK, BRANCH_WIDTH,
             HGRN_KEY, HGRN_KEY, BRANCH_WIDTH, BRANCH_WIDTH,
             N_BRANCH * D_MODEL)
IN_TOTAL = sum(IN_WIDTHS)

kernel_name = 'hybrid_s5_gla_hgrn2_deepnorm'


def layer_norm(x, g, b):
    xf = x.astype(jnp.float32)
    mu = jnp.mean(xf, axis=-1, keepdims=True)
    var = jnp.mean(jnp.square(xf - mu), axis=-1, keepdims=True)
    return ((xf - mu) * lax.rsqrt(var + LN_EPS) * g + b).astype(x.dtype)


def head_rms_norm(o, w):
    of = o.astype(jnp.float32)
    y = of * lax.rsqrt(jnp.mean(jnp.square(of), axis=-1, keepdims=True) + RMS_EPS) * w
    return y.astype(o.dtype)


def split_columns(h):
    bounds, acc = [], 0
    for w in IN_WIDTHS[:-1]:
        acc += w
        bounds.append(acc)
    return jnp.split(h, bounds, axis=-1)


def chunk_gated_linear_attention(q, k, v, log_g):
    bsz, seq, nh, dk = q.shape
    dv = v.shape[-1]
    n_chunks = seq // CHUNK
    n_sub = CHUNK // SUB_CHUNK

    def to_chunks(t):
        return jnp.moveaxis(t.astype(jnp.float32).reshape(bsz, n_chunks, CHUNK, nh, t.shape[-1]), 1, 0)

    later = (jnp.arange(n_sub)[:, None] > jnp.arange(n_sub)[None, :])[:, :, None, None, None]
    causal = (jnp.arange(SUB_CHUNK)[:, None] >= jnp.arange(SUB_CHUNK)[None, :])[:, :, None, None]

    def step(state, inp):
        qc, kc, vc, gc = inp
        gcum = jnp.cumsum(gc, axis=1)
        g_last = gcum[:, -1]
        o = jnp.einsum('blhk,bhkv->blhv', qc * jnp.exp(gcum), state)
        qs = qc.reshape(bsz, n_sub, SUB_CHUNK, nh, dk)
        ks = kc.reshape(bsz, n_sub, SUB_CHUNK, nh, dk)
        vs = vc.reshape(bsz, n_sub, SUB_CHUNK, nh, dv)
        gs = gcum.reshape(bsz, n_sub, SUB_CHUNK, nh, dk)
        g_start = jnp.concatenate([jnp.zeros_like(gs[:, :1, 0]), gs[:, :-1, -1]], axis=1)
        q_ref = qs * jnp.exp(gs - g_start[:, :, None])
        e_off = jnp.where(later, g_start[:, :, None, None] - gs[:, None], -jnp.inf)
        s_off = jnp.einsum('bpihk,bprjhk->bhpirj', q_ref, ks[:, None] * jnp.exp(e_off))
        o_off = jnp.einsum('bhpirj,brjhv->bpihv', s_off, vs)
        e_diag = jnp.where(causal, gs[:, :, :, None] - gs[:, :, None], -jnp.inf)
        s_diag = jnp.einsum('bpihk,bpijhk,bpjhk->bhpij', qs, jnp.exp(e_diag), ks)
        o_diag = jnp.einsum('bhpij,bpjhv->bpihv', s_diag, vs)
        o = o + (o_off + o_diag).reshape(bsz, CHUNK, nh, dv)
        new_state = jnp.exp(g_last)[..., None] * state + jnp.einsum(
            'blhk,blhv->bhkv', kc * jnp.exp(g_last[:, None] - gcum), vc)
        return new_state, o

    init = jnp.zeros((bsz, nh, dk, dv), jnp.float32)
    _, o = lax.scan(step, init, (to_chunks(q), to_chunks(k), to_chunks(v), to_chunks(log_g)))
    return jnp.moveaxis(o, 0, 1).reshape(bsz, seq, nh, dv).astype(v.dtype)


def _complex_scan_combine(left, right):
    a1r, a1i, b1r, b1i = left
    a2r, a2i, b2r, b2i = right
    return (a2r * a1r - a2i * a1i,
            a2r * a1i + a2i * a1r,
            a2r * b1r - a2i * b1i + b2r,
            a2r * b1i + a2i * b1r + b2i)


def s5_branch(u, lam_re, lam_im, log_dt, b_re, b_im, c_re, c_im, d_skip, w_glu, b_glu):
    bsz, seq, _ = u.shape
    f32 = jnp.float32
    ug = u.astype(f32).reshape(bsz, seq, S5_GROUPS, S5_GROUP)
    lr = jnp.minimum(lam_re.astype(f32), -S5_MIN_DECAY)
    li = lam_im.astype(f32)
    dt = jnp.exp(log_dt.astype(f32))[:, None]
    mag = jnp.exp(lr * dt)
    abar_re, abar_im = mag * jnp.cos(li * dt), mag * jnp.sin(li * dt)
    den = lr * lr + li * li
    fac_re = ((abar_re - 1.0) * lr + abar_im * li) / den
    fac_im = (abar_im * lr - (abar_re - 1.0) * li) / den
    br, bi = b_re.astype(f32), b_im.astype(f32)
    bbar_re = fac_re[..., None] * br - fac_im[..., None] * bi
    bbar_im = fac_re[..., None] * bi + fac_im[..., None] * br
    bu_re = jnp.einsum('bsgc,gpc->bsgp', ug, bbar_re)
    bu_im = jnp.einsum('bsgc,gpc->bsgp', ug, bbar_im)
    a_re = jnp.broadcast_to(abar_re[None, None], (1, seq, S5_GROUPS, S5_STATE))
    a_im = jnp.broadcast_to(abar_im[None, None], (1, seq, S5_GROUPS, S5_STATE))
    _, _, s_re, s_im = lax.associative_scan(_complex_scan_combine, (a_re, a_im, bu_re, bu_im), axis=1)
    y = (jnp.einsum('bsgp,gcp->bsgc', s_re, c_re.astype(f32))
         - jnp.einsum('bsgp,gcp->bsgc', s_im, c_im.astype(f32))
         + d_skip.astype(f32).reshape(S5_GROUPS, S5_GROUP) * ug)
    z = jax.nn.gelu(y.reshape(bsz, seq, BRANCH_WIDTH).astype(u.dtype))
    return z * jax.nn.sigmoid(z @ w_glu + b_glu)


def gla_branch(q, k, v, g_low, gate, w_gate, b_gate, norm_w):
    bsz, seq, _ = q.shape
    shp_k = (bsz, seq, GLA_HEADS, GLA_DK)
    shp_v = (bsz, seq, GLA_HEADS, GLA_DV)
    log_a = jax.nn.log_sigmoid((g_low @ w_gate + b_gate).astype(jnp.float32)) / GLA_GATE_TAU
    o = chunk_gated_linear_attention((q * GLA_DK ** -0.5).reshape(shp_k), k.reshape(shp_k),
                                     v.reshape(shp_v), log_a.reshape(shp_k))
    o = head_rms_norm(o, norm_w) * jax.nn.silu(gate).reshape(shp_v)
    return o.reshape(bsz, seq, BRANCH_WIDTH)


def hgrn2_branch(q, f_logit, i, gate, lb, norm_w):
    bsz, seq, _ = q.shape
    shp_k = (bsz, seq, HGRN_HEADS, HGRN_EXPAND)
    shp_v = (bsz, seq, HGRN_HEADS, HGRN_DV)
    f = (lb + (1.0 - lb) * jax.nn.sigmoid(f_logit.astype(jnp.float32))).reshape(shp_k)
    o = chunk_gated_linear_attention(jax.nn.silu(q).reshape(shp_k), 1.0 - f,
                                     i.reshape(shp_v), jnp.log(f))
    o = head_rms_norm(o * jax.nn.sigmoid(gate).reshape(shp_v), norm_w)
    return o.reshape(bsz, seq, BRANCH_WIDTH)


def hybrid_mixer(x, w_in, s5_lam_re, s5_lam_im, s5_log_dt, s5_b_re, s5_b_im, s5_c_re, s5_c_im,
                 s5_d, s5_w_glu, s5_b_glu, gla_w_gate, gla_b_gate, gla_norm_w, lb, hgrn_norm_w,
                 w_up, w_out):
    bsz, seq, _ = x.shape
    h = jnp.einsum('bsd,dn->bsn', x, w_in)
    (u_a, q_b, k_b, v_b, glow_b, gate_b, q_c, f_c, i_c, gate_c, merge_gates) = split_columns(h)
    y_a = s5_branch(u_a, s5_lam_re, s5_lam_im, s5_log_dt, s5_b_re, s5_b_im, s5_c_re, s5_c_im,
                    s5_d, s5_w_glu, s5_b_glu)
    y_b = gla_branch(q_b, k_b, v_b, glow_b, gate_b, gla_w_gate, gla_b_gate, gla_norm_w)
    y_c = hgrn2_branch(q_c, f_c, i_c, gate_c, lb, hgrn_norm_w)
    ys = jnp.stack([y_a, y_b, y_c], axis=2)
    up = jnp.einsum('bsnw,nwd->bsnd', ys, w_up)
    g = jax.nn.sigmoid(merge_gates.reshape(bsz, seq, N_BRANCH, D_MODEL))
    merged = jnp.sum(g * up, axis=2)
    return merged @ w_out


def squared_relu_mlp(x, w1, w2):
    return jnp.square(jax.nn.relu(x @ w1)) @ w2


def setup_inputs(seed: int = 0) -> dict:
    key = jax.random.key(seed)
    ks = jax.random.split(key, 25)
    f32 = jnp.float32
    L, D, W, G, P, C = DEPTH, D_MODEL, BRANCH_WIDTH, S5_GROUPS, S5_STATE, S5_GROUP

    def nrm(k, shape, scale):
        return jax.random.normal(k, shape, f32) * scale

    return {
        'x': nrm(ks[0], (BATCH, SEQ, D), 1.0),
        'w_in': nrm(ks[1], (L, D, IN_TOTAL), D ** -0.5),
        's5_lam_re': -0.5 + nrm(ks[2], (L, G, P), 0.01),
        's5_lam_im': jnp.pi * jnp.arange(P, dtype=f32) + nrm(ks[3], (L, G, P), 0.01),
        's5_log_dt': jax.random.uniform(ks[4], (L, G), f32, math.log(S5_DT_MIN), math.log(S5_DT_MAX)),
        's5_b_re': nrm(ks[5], (L, G, P, C), C ** -0.5),
        's5_b_im': nrm(ks[6], (L, G, P, C), C ** -0.5),
        's5_c_re': nrm(ks[7], (L, G, C, P), P ** -0.5),
        's5_c_im': nrm(ks[8], (L, G, C, P), P ** -0.5),
        's5_d': nrm(ks[9], (L, W), 1.0),
        's5_w_glu': nrm(ks[10], (L, W, W), W ** -0.5),
        's5_b_glu': nrm(ks[11], (L, W), 0.01),
        'gla_w_gate': nrm(ks[12], (L, GLA_GATE_RANK, GLA_KEY), GLA_GATE_RANK ** -0.5),
        'gla_b_gate': nrm(ks[13], (L, GLA_KEY), 0.01),
        'gla_norm_w': 1.0 + nrm(ks[14], (L, GLA_DV), 0.02),
        'hgrn_lb_logits': nrm(ks[15], (L, HGRN_KEY), 0.1),
        'hgrn_norm_w': 1.0 + nrm(ks[16], (L, HGRN_DV), 0.02),
        'w_up': nrm(ks[17], (L, N_BRANCH, W, D), W ** -0.5),
        'w_out': nrm(ks[18], (L, D, D), D ** -0.5 * DN_BETA),
        'ln1_g': 1.0 + nrm(ks[19], (L, D), 0.02),
        'ln1_b': nrm(ks[20], (L, D), 0.01),
        'ln2_g': 1.0 + nrm(ks[21], (L, D), 0.02),
        'ln2_b': nrm(ks[22], (L, D), 0.01),
        'w_mlp_in': nrm(ks[23], (L, D, MLP_HIDDEN), D ** -0.5),
        'w_mlp_out': nrm(ks[24], (L, MLP_HIDDEN, D), MLP_HIDDEN ** -0.5 * DN_BETA),
    }


def reference(x, w_in, s5_lam_re, s5_lam_im, s5_log_dt, s5_b_re, s5_b_im, s5_c_re, s5_c_im, s5_d,
              s5_w_glu, s5_b_glu, gla_w_gate, gla_b_gate, gla_norm_w, hgrn_lb_logits, hgrn_norm_w,
              w_up, w_out, ln1_g, ln1_b, ln2_g, ln2_b, w_mlp_in, w_mlp_out):
    p = jax.nn.softmax(hgrn_lb_logits.astype(jnp.float32), axis=0)
    lb = jnp.cumsum(p, axis=0) - p[0]
    for l in range(DEPTH):
        mix = hybrid_mixer(x, w_in[l], s5_lam_re[l], s5_lam_im[l], s5_log_dt[l], s5_b_re[l], s5_b_im[l],
                           s5_c_re[l], s5_c_im[l], s5_d[l], s5_w_glu[l], s5_b_glu[l], gla_w_gate[l],
                           gla_b_gate[l], gla_norm_w[l], lb[l], hgrn_norm_w[l], w_up[l], w_out[l])
        x = layer_norm(DN_ALPHA * x + mix, ln1_g[l], ln1_b[l])
        x = layer_norm(DN_ALPHA * x + squared_relu_mlp(x, w_mlp_in[l], w_mlp_out[l]), ln2_g[l], ln2_b[l])
    return x
```

```cpp
#include <hip/hip_runtime.h>
#include <cstdio>
#include <cstdint>
namespace pg8 {
#define PG8_LAS __attribute__((address_space(3)))
typedef unsigned short bf16_t;
typedef short bf16x8 __attribute__((ext_vector_type(8)));
typedef float f32x4 __attribute__((ext_vector_type(4)));
typedef unsigned u32x4 __attribute__((ext_vector_type(4)));
constexpr int BM = 256, BK = 64, HALF = 128, HTB = HALF * BK * 2  , STAGE_BYTES = 8 * HTB, NXCD = 8, WGM = 8;

__host__ __device__ __forceinline__ int lds_byte(int r, int c) { const int st = (r >> 4) * 2 + (c >> 5), rr = r & 15, cc = c & 31, ob = rr * 64 + cc * 2; return st * 1024 + (ob ^ (((ob >> 9) & 1) << 5)); }
__host__ __device__ __forceinline__ void stage_rc(int b, int& R, int& C) { const int st = b / 1024, sb = b % 1024, swz = sb ^ (((sb >> 9) & 1) << 5); R = (st >> 1) * 16 + swz / 64; C = (st & 1) * 32 + (swz % 64) / 2; }
__host__ __device__ __forceinline__ int perm32(int rho) { const int n = rho >> 4, i = rho & 15; return 8 * (i >> 2) + 4 * n + (i & 3); }

struct Unit { int pm, pn; };
struct Gemm { const bf16_t* A; const bf16_t* Bt; int M, N, K; };

struct StaticOrder {
    int nM, nN, nwg, G, c, wgm;
    __host__ __device__ void init(int M, int N, int G_, int c_, int wgm_ = WGM) { nM = M / BM; nN = N / BM; nwg = nM * nN; G = G_; c = c_; wgm = wgm_; }
    __host__ __device__ bool next(int i, Unit& u) const {
        const long L = (long)i * G + c; if (L >= nwg) return false;
        int wgid = (int)L; { const int q = nwg / NXCD, r = nwg % NXCD, xcd = wgid % NXCD, off = wgid / NXCD; wgid = (xcd < r ? xcd * (q + 1) : r * (q + 1) + (xcd - r) * q) + off; }
        const int nig = wgm * nN, gid = wgid / nig, fm = gid * wgm, gsz = (nM - fm) < wgm ? (nM - fm) : wgm;
        u.pm = fm + ((wgid % nig) % gsz); u.pn = (wgid % nig) / gsz; return true;
    }
    __device__ __forceinline__ void a_ready(const Unit&) const {}
    __device__ __forceinline__ void done(const Unit&) const {}
};

__device__ __forceinline__ unsigned cvt_pk_bf16(float lo, float hi) { unsigned r; asm volatile("v_cvt_pk_bf16_f32 %0, %1, %2" : "=v"(r) : "v"(lo), "v"(hi)); return r; }
typedef float f32x2 __attribute__((ext_vector_type(2)));

typedef unsigned u32x2 __attribute__((ext_vector_type(2)));
__device__ __forceinline__ float bf_lo(unsigned w) { return __uint_as_float(w << 16); }
__device__ __forceinline__ float bf_hi(unsigned w) { return __uint_as_float(w & 0xffff0000u); }
__device__ __forceinline__ float sigmoidf_(float x) { return __builtin_amdgcn_rcpf(1.0f + __expf(-x)); }

typedef _Float16 f16x2_ __attribute__((ext_vector_type(2)));
__device__ __forceinline__ unsigned cvt_pk_f16(float lo, float hi) { const f32x2 v = {lo, hi}; const f16x2_ h = __builtin_convertvector(v, f16x2_); return __builtin_bit_cast(unsigned, h); }
__device__ __forceinline__ f32x2 unpk_f16(unsigned w) { const f16x2_ h = __builtin_bit_cast(f16x2_, w); return __builtin_convertvector(h, f32x2); }
struct EpiBf16Plain {
    static constexpr bool PERM = true, AFTER_DRAIN = false;
    bf16_t* O; int ldc;
    __device__ __forceinline__ void operator()(const f32x4 (&acc)[2][2][4][2], const Unit& u, int wr, int wc, int fr, int fq) const {
        const int row0 = u.pm * BM + wr * 64 + fr, col0 = u.pn * BM + wc * 32 + 8 * fq;
#pragma unroll
        for (int ai = 0; ai < 2; ++ai)
#pragma unroll
            for (int m = 0; m < 4; ++m) { bf16_t* rowp = O + (size_t)(row0 + ai * HALF + m * 16) * ldc + col0;
#pragma unroll
                for (int bj = 0; bj < 2; ++bj) { const f32x4 v0 = acc[ai][bj][m][0], v1 = acc[ai][bj][m][1];
                    u32x4 w; w.x = cvt_pk_bf16(v0[0], v0[1]); w.y = cvt_pk_bf16(v0[2], v0[3]); w.z = cvt_pk_bf16(v1[0], v1[1]); w.w = cvt_pk_bf16(v1[2], v1[3]);
                    *(u32x4*)(rowp + bj * HALF) = w; } }
    }
};
struct EpiH {
    static constexpr bool PERM = true, AFTER_DRAIN = false;
    bf16_t* O; int ldc; bf16_t* U;
    __device__ __forceinline__ void operator()(const f32x4 (&acc)[2][2][4][2], const Unit& u, int wr, int wc, int fr, int fq) const {
        const int row0 = u.pm * BM + wr * 64 + fr, col0 = u.pn * BM + wc * 32 + 8 * fq;
        const bool isu = u.pn < 4, isg = u.pn >= 32;
#pragma unroll
        for (int ai = 0; ai < 2; ++ai)
#pragma unroll
            for (int m = 0; m < 4; ++m) { const int row = row0 + ai * HALF + m * 16;
#pragma unroll
                for (int bj = 0; bj < 2; ++bj) { f32x4 v0 = acc[ai][bj][m][0], v1 = acc[ai][bj][m][1];
                    if (isg) {
#pragma unroll
                        for (int j = 0; j < 4; ++j) { v0[j] = 1.0f + __expf(-fminf(fmaxf(v0[j], -30.f), 30.f)); v1[j] = 1.0f + __expf(-fminf(fmaxf(v1[j], -30.f), 30.f)); } }
                    u32x4 w; w.x = cvt_pk_bf16(v0[0], v0[1]); w.y = cvt_pk_bf16(v0[2], v0[3]); w.z = cvt_pk_bf16(v1[0], v1[1]); w.w = cvt_pk_bf16(v1[2], v1[3]);
                    const int col = col0 + bj * HALF;
                    bf16_t* dst = isu ? U + ((size_t)((row >> 12) * 64 + (col >> 4)) * 4096 + (row & 4095)) * 16 + (col & 8) : O + (size_t)row * ldc + col;
                    *(u32x4*)dst = w; } }
    }
};
struct EpiRelu2 {
    static constexpr bool PERM = true, AFTER_DRAIN = false;
    bf16_t* O; int ldc;
    __device__ __forceinline__ void operator()(const f32x4 (&acc)[2][2][4][2], const Unit& u, int wr, int wc, int fr, int fq) const {
        const int row0 = u.pm * BM + wr * 64 + fr, col0 = u.pn * BM + wc * 32 + 8 * fq;
#pragma unroll
        for (int ai = 0; ai < 2; ++ai)
#pragma unroll
            for (int m = 0; m < 4; ++m) { bf16_t* rowp = O + (size_t)(row0 + ai * HALF + m * 16) * ldc + col0;
#pragma unroll
                for (int bj = 0; bj < 2; ++bj) { f32x4 v0 = acc[ai][bj][m][0], v1 = acc[ai][bj][m][1];
#pragma unroll
                    for (int j = 0; j < 4; ++j) { const float a = fmaxf(v0[j], 0.f), b = fmaxf(v1[j], 0.f); v0[j] = a * a; v1[j] = b * b; }
                    u32x4 w; w.x = cvt_pk_bf16(v0[0], v0[1]); w.y = cvt_pk_bf16(v0[2], v0[3]); w.z = cvt_pk_bf16(v1[0], v1[1]); w.w = cvt_pk_bf16(v1[2], v1[3]);
                    *(u32x4*)(rowp + bj * HALF) = w; } }
    }
};
struct EpiGlu {
    static constexpr bool PERM = true, AFTER_DRAIN = false;
    bf16_t* O; int ldc; const bf16_t* Z; int ldz; const float* bias;
    __device__ __forceinline__ void operator()(const f32x4 (&acc)[2][2][4][2], const Unit& u, int wr, int wc, int fr, int fq) const {
        const int row0 = u.pm * BM + wr * 64 + fr, col0 = u.pn * BM + wc * 32 + 8 * fq;
        f32x4 bv[2][2];
#pragma unroll
        for (int bj = 0; bj < 2; ++bj)
#pragma unroll
            for (int n = 0; n < 2; ++n) bv[bj][n] = *(const f32x4*)(bias + col0 + bj * HALF + 4 * n);
#pragma unroll
        for (int ai = 0; ai < 2; ++ai)
#pragma unroll
            for (int m = 0; m < 4; ++m) { const size_t r = (size_t)(row0 + ai * HALF + m * 16);
#pragma unroll
                for (int bj = 0; bj < 2; ++bj) { f32x4 v0 = acc[ai][bj][m][0] + bv[bj][0], v1 = acc[ai][bj][m][1] + bv[bj][1];
                    const u32x4 zz = *(const u32x4*)(Z + r * ldz + col0 + bj * HALF);
                    v0[0] = bf_lo(zz.x) * sigmoidf_(v0[0]); v0[1] = bf_hi(zz.x) * sigmoidf_(v0[1]); v0[2] = bf_lo(zz.y) * sigmoidf_(v0[2]); v0[3] = bf_hi(zz.y) * sigmoidf_(v0[3]);
                    v1[0] = bf_lo(zz.z) * sigmoidf_(v1[0]); v1[1] = bf_hi(zz.z) * sigmoidf_(v1[1]); v1[2] = bf_lo(zz.w) * sigmoidf_(v1[2]); v1[3] = bf_hi(zz.w) * sigmoidf_(v1[3]);
                    u32x4 w; w.x = cvt_pk_bf16(v0[0], v0[1]); w.y = cvt_pk_bf16(v0[2], v0[3]); w.z = cvt_pk_bf16(v1[0], v1[1]); w.w = cvt_pk_bf16(v1[2], v1[3]);
                    *(u32x4*)(O + r * ldc + col0 + bj * HALF) = w; } }
    }
};
struct EpiRes {
    static constexpr bool PERM = true, AFTER_DRAIN = false, HAS_INIT = true;
    static constexpr int ldc = 2048; static constexpr float alpha = 1.681792830507429f;
    bf16_t* Y; const bf16_t* X;
    const float* ST; const float* GB;
    __device__ __forceinline__ void init(f32x4 (&acc)[2][2][4][2], const Unit& u, int wr, int wc, int fr_, int fq) const {
        int fr = fr_; asm volatile("" : "+v"(fr));
        const int row0 = u.pm * BM + wr * 64 + fr, col0 = u.pn * BM + wc * 32 + 8 * fq;
#pragma unroll
        for (int ai = 0; ai < 2; ++ai)
#pragma unroll
            for (int m = 0; m < 4; ++m) { const bf16_t* rp = X + (size_t)(row0 + ai * HALF + m * 16) * ldc + col0;
#pragma unroll
                for (int bj = 0; bj < 2; ++bj) { const u32x4 w = *(const u32x4*)(rp + bj * HALF);
                    const f32x2 a = unpk_f16(w.x), b = unpk_f16(w.y), c = unpk_f16(w.z), d = unpk_f16(w.w);
                    acc[ai][bj][m][0] = (f32x4){a.x, a.y, b.x, b.y}; acc[ai][bj][m][1] = (f32x4){c.x, c.y, d.x, d.y}; } }
        f32x2 st[2][4];
#pragma unroll
        for (int ai = 0; ai < 2; ++ai)
#pragma unroll
            for (int m = 0; m < 4; ++m) st[ai][m] = *(const f32x2*)(ST + 2 * (size_t)(row0 + ai * HALF + m * 16));
#pragma unroll
        for (int bj = 0; bj < 2; ++bj)
#pragma unroll
            for (int n = 0; n < 2; ++n) { const int c = col0 + bj * HALF + n * 4;
                const f32x4 gv = *(const f32x4*)(GB + c) * alpha, bv = *(const f32x4*)(GB + ldc + c) * alpha;
#pragma unroll
                for (int ai = 0; ai < 2; ++ai)
#pragma unroll
                    for (int m = 0; m < 4; ++m) acc[ai][bj][m][n] = (acc[ai][bj][m][n] - st[ai][m].x) * st[ai][m].y * gv + bv; }
    }
    __device__ __forceinline__ void operator()(const f32x4 (&acc)[2][2][4][2], const Unit& u, int wr, int wc, int fr, int fq) const {
        const int row0 = u.pm * BM + wr * 64 + fr, col0 = u.pn * BM + wc * 32 + 8 * fq;
#pragma unroll
        for (int ai = 0; ai < 2; ++ai)
#pragma unroll
            for (int m = 0; m < 4; ++m) { bf16_t* rowp = Y + (size_t)(row0 + ai * HALF + m * 16) * ldc + col0;
#pragma unroll
                for (int bj = 0; bj < 2; ++bj) { const f32x4 v0 = acc[ai][bj][m][0], v1 = acc[ai][bj][m][1];
                    u32x4 w; w.x = cvt_pk_f16(v0[0], v0[1]); w.y = cvt_pk_f16(v0[2], v0[3]); w.z = cvt_pk_f16(v1[0], v1[1]); w.w = cvt_pk_f16(v1[2], v1[3]);
                    *(u32x4*)(rowp + bj * HALF) = w; } }
    }
};
template <int MODE> struct EpiMerge {
    static constexpr bool PERM = false, AFTER_DRAIN = false;
    float* T; bf16_t* O; int ldc; const bf16_t* G; int ldg;
    __device__ __forceinline__ void operator()(const f32x4 (&acc)[2][2][4][2], const Unit& u, int wr, int wc, int fr, int fq) const {
        const int row0 = u.pm * BM + wr * 64 + fr, col0 = u.pn * BM + wc * 32 + 4 * fq;
#pragma unroll
        for (int ai = 0; ai < 2; ++ai)
#pragma unroll
            for (int m = 0; m < 4; ++m) { const size_t r = (size_t)(row0 + ai * HALF + m * 16);
#pragma unroll
                for (int bj = 0; bj < 2; ++bj)
#pragma unroll
                    for (int n = 0; n < 2; ++n) { const int c = col0 + bj * HALF + n * 16;
                        const u32x2 gg = *(const u32x2*)(G + r * ldg + c);
                        f32x4 gv; gv[0] = sigmoidf_(bf_lo(gg.x)); gv[1] = sigmoidf_(bf_hi(gg.x)); gv[2] = sigmoidf_(bf_lo(gg.y)); gv[3] = sigmoidf_(bf_hi(gg.y));
                        f32x4 v = gv * acc[ai][bj][m][n];
                        if (MODE != 0) v = v + *(const f32x4*)(T + r * ldc + c);
                        if (MODE != 2) *(f32x4*)(T + r * ldc + c) = v;
                        else { u32x2 w; w.x = cvt_pk_bf16(v[0], v[1]); w.y = cvt_pk_bf16(v[2], v[3]); *(u32x2*)(O + r * ldc + c) = w; } } }
    }
};

struct EpiMergeK {
    static constexpr bool PERM = true, AFTER_DRAIN = false, HAS_HOOK = true;
    bf16_t* O; int ldc; const bf16_t* G; int ldg; int gstride;
    __device__ __forceinline__ void hook(f32x4 (&acc)[2][2][4][2], const Unit& u, int seam, int wr, int wc, int fr_, int fq) const {
        int fr = fr_; asm volatile("" : "+v"(fr));
        const int row0 = u.pm * BM + wr * 64 + fr, col0 = u.pn * BM + wc * 32 + 8 * fq;
        const bf16_t* gd = G + (size_t)(seam - 1) * gstride; const bf16_t* gn = gd + gstride;
#pragma unroll
        for (int ai = 0; ai < 2; ++ai) {
            u32x4 a[4][2], b[4][2];
#pragma unroll
            for (int m = 0; m < 4; ++m) { const size_t r = (size_t)(row0 + ai * HALF + m * 16) * ldg + col0;
#pragma unroll
                for (int bj = 0; bj < 2; ++bj) { a[m][bj] = *(const u32x4*)(gn + r + bj * HALF); b[m][bj] = *(const u32x4*)(gd + r + bj * HALF); } }
#pragma unroll
            for (int m = 0; m < 4; ++m)
#pragma unroll
                for (int bj = 0; bj < 2; ++bj) { const u32x4 x = a[m][bj], y = b[m][bj];
                    f32x4 q0, q1;
                    q0[0] = bf_lo(x.x) * __builtin_amdgcn_rcpf(bf_lo(y.x)); q0[1] = bf_hi(x.x) * __builtin_amdgcn_rcpf(bf_hi(y.x)); q0[2] = bf_lo(x.y) * __builtin_amdgcn_rcpf(bf_lo(y.y)); q0[3] = bf_hi(x.y) * __builtin_amdgcn_rcpf(bf_hi(y.y));
                    q1[0] = bf_lo(x.z) * __builtin_amdgcn_rcpf(bf_lo(y.z)); q1[1] = bf_hi(x.z) * __builtin_amdgcn_rcpf(bf_hi(y.z)); q1[2] = bf_lo(x.w) * __builtin_amdgcn_rcpf(bf_lo(y.w)); q1[3] = bf_hi(x.w) * __builtin_amdgcn_rcpf(bf_hi(y.w));
                    acc[ai][bj][m][0] = acc[ai][bj][m][0] * q0; acc[ai][bj][m][1] = acc[ai][bj][m][1] * q1; }
            asm volatile("" ::: "memory"); }
    }
    __device__ __forceinline__ void operator()(const f32x4 (&acc)[2][2][4][2], const Unit& u, int wr, int wc, int fr, int fq) const {
        const int row0 = u.pm * BM + wr * 64 + fr, col0 = u.pn * BM + wc * 32 + 8 * fq;
        const bf16_t* g2 = G + (size_t)2 * gstride;
#pragma unroll
        for (int ai = 0; ai < 2; ++ai)
#pragma unroll
            for (int m = 0; m < 4; ++m) { const size_t r = (size_t)(row0 + ai * HALF + m * 16);
#pragma unroll
                for (int bj = 0; bj < 2; ++bj) { const u32x4 a = *(const u32x4*)(g2 + r * ldg + col0 + bj * HALF);
                    const f32x4 v0 = acc[ai][bj][m][0], v1 = acc[ai][bj][m][1];
#define RG_(x) __builtin_amdgcn_rcpf(x)
                    u32x4 w; w.x = cvt_pk_bf16(v0[0] * RG_(bf_lo(a.x)), v0[1] * RG_(bf_hi(a.x))); w.y = cvt_pk_bf16(v0[2] * RG_(bf_lo(a.y)), v0[3] * RG_(bf_hi(a.y)));
                    w.z = cvt_pk_bf16(v1[0] * RG_(bf_lo(a.z)), v1[1] * RG_(bf_hi(a.z))); w.w = cvt_pk_bf16(v1[2] * RG_(bf_lo(a.w)), v1[3] * RG_(bf_hi(a.w)));
#undef RG_
                    *(u32x4*)(O + r * ldc + col0 + bj * HALF) = w; } }
    }
};
template <class E, class = void> struct epi_has_init { static constexpr bool value = false; };
template <class E> struct epi_has_init<E, decltype((void)E::HAS_INIT)> { static constexpr bool value = E::HAS_INIT; };
template <class E, class = void> struct epi_has_hook { static constexpr bool value = false; };
template <class E> struct epi_has_hook<E, decltype((void)E::HAS_HOOK)> { static constexpr bool value = E::HAS_HOOK; };

template <class Epi, class Sched, bool ALIGN_EPI = false, bool SP2 = false>
__device__ __forceinline__ void gemm_phase_ld(PG8_LAS unsigned char* lds, const Gemm g, const int lda, const int ldb, const Sched& S, const Epi& E) {
    int tid_ = threadIdx.x; asm volatile("" : "+v"(tid_));
    const int tid = tid_, wid = __builtin_amdgcn_readfirstlane(tid >> 6), lane = tid & 63, wr = wid >> 2, wc = wid & 3, fr = lane & 15, fq = lane >> 4;
    const int K = g.K, nt = K / BK;
    unsigned voffA[2], voffB[2];
#pragma unroll
    for (int i = 0; i < 2; ++i) { int R, C; stage_rc(tid * 16 + i * 8192, R, C); const int Rb = Epi::PERM ? ((R & ~31) + perm32(R & 31)) : R;
        voffA[i] = (unsigned)(R * lda + C) * 2u; voffB[i] = (unsigned)(Rb * ldb + C) * 2u; }
    const size_t kstep = (size_t)(BK * 2);
    const size_t hstepA = (size_t)HALF * lda * 2, hstepB = (size_t)HALF * ldb * 2;
    const size_t tstepA = 2 * hstepA, tstepB = 2 * hstepB;
    const unsigned ldsw = (unsigned)wid * 1024u;
    const int aoff = lds_byte(wr * 64 + fr, fq * 8), boff = lds_byte(wc * 32 + fr, fq * 8);
#define PG8_SA(b, h) (((b) * 2 + (h)) * HTB)
#define PG8_SB(b, h) ((4 + (b) * 2 + (h)) * HTB)
#define PG8_STAGE(bufoff, gbase, voff) do { _Pragma("unroll") for (int _i = 0; _i < 2; ++_i) \
        __builtin_amdgcn_global_load_lds((const unsigned*)((const char*)(gbase) + (voff)[_i]), (PG8_LAS unsigned*)(lds + (bufoff) + ldsw + _i * 8192), 16, 0, 0); } while (0)
#define PG8_LDA(dst, b, h) do { _Pragma("unroll") for (int m = 0; m < 4; ++m) _Pragma("unroll") for (int k = 0; k < 2; ++k) dst[m][k] = *(const PG8_LAS bf16x8*)(lds + PG8_SA(b, h) + aoff + m * 2048 + k * 1024); } while (0)
#define PG8_LDB(dst, b, h) do { _Pragma("unroll") for (int n = 0; n < 2; ++n) _Pragma("unroll") for (int k = 0; k < 2; ++k) dst[n][k] = *(const PG8_LAS bf16x8*)(lds + PG8_SB(b, h) + boff + n * 2048 + k * 1024); } while (0)
#define PG8_MMA(ai, bj, At, Bt) do { __builtin_amdgcn_s_setprio(1); _Pragma("unroll") for (int m = 0; m < 4; ++m) _Pragma("unroll") for (int n = 0; n < 2; ++n) _Pragma("unroll") for (int k = 0; k < 2; ++k) \
        acc[ai][bj][m][n] = __builtin_amdgcn_mfma_f32_16x16x32_bf16(Bt[n][k], At[m][k], acc[ai][bj][m][n], 0, 0, 0); __builtin_amdgcn_s_setprio(0); } while (0)
#define PG8_WAIT_V(n) asm volatile("s_waitcnt vmcnt(" #n ")" ::: "memory")
#define PG8_WAIT_L(n) asm volatile("s_waitcnt lgkmcnt(" #n ")" ::: "memory")
#define PG8_BAR __builtin_amdgcn_s_barrier()
#define PG8_SCHED __builtin_amdgcn_sched_barrier(0)
    Unit cur, nxt; int ui = 0;
    if (!S.next(0, cur)) return;
    f32x4 acc[2][2][4][2];
    if constexpr (epi_has_init<Epi>::value) E.init(acc, cur, wr, wc, fr, fq);
    else {
#pragma unroll
    for (int a = 0; a < 2; ++a)
#pragma unroll
        for (int b = 0; b < 2; ++b)
#pragma unroll
            for (int m = 0; m < 4; ++m)
#pragma unroll
                for (int n = 0; n < 2; ++n) acc[a][b][m][n] = (f32x4){0.f, 0.f, 0.f, 0.f};
    }
    bf16x8 At[4][2], B0[2][2], B1[2][2];
    const char* cA = (const char*)g.A + (size_t)cur.pm * tstepA; const char* cB = (const char*)g.Bt + (size_t)cur.pn * tstepB;
    S.a_ready(cur);
    if constexpr (SP2) {
        PG8_STAGE(PG8_SB(0, 0), cB, voffB); PG8_STAGE(PG8_SB(0, 1), cB + hstepB, voffB); PG8_STAGE(PG8_SA(0, 0), cA, voffA); PG8_STAGE(PG8_SA(0, 1), cA + hstepA, voffA);
        if (wr == 1) PG8_BAR;
        PG8_WAIT_V(2); PG8_BAR;
        PG8_STAGE(PG8_SB(1, 0), cB + kstep, voffB); PG8_STAGE(PG8_SA(1, 0), cA + kstep, voffA); PG8_STAGE(PG8_SB(1, 1), cB + hstepB + kstep, voffB);
        PG8_WAIT_V(6); PG8_BAR;
    } else {
        PG8_STAGE(PG8_SB(0, 0), cB, voffB); PG8_STAGE(PG8_SA(0, 0), cA, voffA); PG8_STAGE(PG8_SB(0, 1), cB + hstepB, voffB); PG8_STAGE(PG8_SA(0, 1), cA + hstepA, voffA);
        if (wr == 1) PG8_BAR;
        PG8_WAIT_V(4); PG8_BAR;
        PG8_STAGE(PG8_SB(1, 0), cB + kstep, voffB); PG8_STAGE(PG8_SA(1, 0), cA + kstep, voffA); PG8_STAGE(PG8_SB(1, 1), cB + hstepB + kstep, voffB);
        PG8_WAIT_V(6); PG8_BAR;
    }
    for (;;) {
        const bool has_next = S.next(ui + 1, nxt);
        const char* nA = has_next ? (const char*)g.A + (size_t)nxt.pm * tstepA : cA; const char* nB = has_next ? (const char*)g.Bt + (size_t)nxt.pn * tstepB : cB;
        for (int t = 0; t < nt; t += 2) {
            const bool last = (t == nt - 2);
            const char* a1 = cA + (size_t)(t + 1) * kstep;
            const char* a2 = last ? nA : cA + (size_t)(t + 2) * kstep; const char* b2 = last ? nB : cB + (size_t)(t + 2) * kstep;
            const char* a3 = a2 + kstep; const char* b3 = b2 + kstep;
            if (last && has_next) S.a_ready(nxt);
            if constexpr (epi_has_hook<Epi>::value) { if (t == 16 || t == 32) { f32x4 (&acc_)[2][2][4][2] = acc; E.hook(acc_, cur, t >> 4, wr, wc, fr, fq); } }
            if constexpr (SP2) {
            PG8_LDB(B0, 0, 0); PG8_LDB(B1, 0, 1); PG8_SCHED; PG8_LDA(At, 0, 0); PG8_STAGE(PG8_SA(1, 1), a1 + hstepA, voffA);
            PG8_WAIT_V(8); PG8_WAIT_L(0); PG8_BAR; PG8_MMA(0, 0, At, B0); PG8_MMA(0, 1, At, B1); PG8_BAR; PG8_SCHED;
            PG8_LDA(At, 0, 1); PG8_STAGE(PG8_SB(0, 0), b2, voffB); PG8_STAGE(PG8_SB(0, 1), b2 + hstepB, voffB); PG8_STAGE(PG8_SA(0, 0), a2, voffA);
            PG8_WAIT_V(8); PG8_WAIT_L(0); PG8_BAR; PG8_MMA(1, 0, At, B0); PG8_MMA(1, 1, At, B1); PG8_BAR; PG8_SCHED;
            PG8_LDB(B0, 1, 0); PG8_LDB(B1, 1, 1); PG8_SCHED; PG8_LDA(At, 1, 0); PG8_STAGE(PG8_SA(0, 1), a2 + hstepA, voffA);
            PG8_WAIT_V(8); PG8_WAIT_L(0); PG8_BAR; PG8_MMA(0, 0, At, B0); PG8_MMA(0, 1, At, B1); PG8_BAR; PG8_SCHED;
            PG8_LDA(At, 1, 1); PG8_STAGE(PG8_SB(1, 0), b3, voffB); PG8_STAGE(PG8_SB(1, 1), b3 + hstepB, voffB); PG8_STAGE(PG8_SA(1, 0), a3, voffA);
            PG8_WAIT_V(8); PG8_WAIT_L(0); PG8_BAR; PG8_MMA(1, 0, At, B0); PG8_MMA(1, 1, At, B1); PG8_BAR; PG8_SCHED;
            } else {
            PG8_LDB(B0, 0, 0); PG8_SCHED; PG8_LDA(At, 0, 0); PG8_STAGE(PG8_SA(1, 1), a1 + hstepA, voffA);
            PG8_WAIT_L(8); PG8_BAR; PG8_WAIT_L(0); PG8_MMA(0, 0, At, B0); PG8_BAR; PG8_SCHED;
            PG8_LDB(B1, 0, 1); PG8_STAGE(PG8_SB(0, 0), b2, voffB);
            PG8_BAR; PG8_WAIT_L(0); PG8_MMA(0, 1, At, B1); PG8_BAR;
            PG8_LDA(At, 0, 1); PG8_STAGE(PG8_SA(0, 0), a2, voffA);
            PG8_BAR; PG8_WAIT_L(0); PG8_MMA(1, 0, At, B0); PG8_BAR; PG8_SCHED;
            PG8_STAGE(PG8_SB(0, 1), b2 + hstepB, voffB);
            PG8_WAIT_V(6); PG8_BAR; PG8_MMA(1, 1, At, B1); PG8_BAR;
            PG8_LDB(B0, 1, 0); PG8_SCHED; PG8_LDA(At, 1, 0); PG8_STAGE(PG8_SA(0, 1), a2 + hstepA, voffA);
            PG8_WAIT_L(8); PG8_BAR; PG8_WAIT_L(0); PG8_MMA(0, 0, At, B0); PG8_BAR; PG8_SCHED;
            PG8_LDB(B1, 1, 1); PG8_STAGE(PG8_SB(1, 0), b3, voffB);
            PG8_BAR; PG8_WAIT_L(0); PG8_MMA(0, 1, At, B1); PG8_BAR;
            PG8_LDA(At, 1, 1); PG8_STAGE(PG8_SA(1, 0), a3, voffA);
            PG8_BAR; PG8_WAIT_L(0); PG8_MMA(1, 0, At, B0); PG8_BAR; PG8_SCHED;
            PG8_STAGE(PG8_SB(1, 1), b3 + hstepB, voffB);
            PG8_WAIT_V(6); PG8_BAR; PG8_MMA(1, 1, At, B1); PG8_BAR;
            }
        }
        if constexpr (ALIGN_EPI) { if (wr == 0) PG8_BAR; }
        if constexpr (!Epi::AFTER_DRAIN) { E(acc, cur, wr, wc, fr, fq); S.done(cur); }
        if (!has_next) break;
        if constexpr (epi_has_init<Epi>::value) E.init(acc, nxt, wr, wc, fr, fq);
        else {
#pragma unroll
        for (int a = 0; a < 2; ++a)
#pragma unroll
            for (int b = 0; b < 2; ++b)
#pragma unroll
                for (int m = 0; m < 4; ++m)
#pragma unroll
                    for (int n = 0; n < 2; ++n) acc[a][b][m][n] = (f32x4){0.f, 0.f, 0.f, 0.f};
        }
        cur = nxt; cA = nA; cB = nB; ++ui;
        if constexpr (ALIGN_EPI) { if (wr == 1) PG8_BAR; }
    }
    PG8_WAIT_V(0);
    if constexpr (!ALIGN_EPI) { if (wr == 0) PG8_BAR; }
    PG8_BAR;
    if constexpr (Epi::AFTER_DRAIN) { E.fused(acc, cur, wr, wc, fr, fq, lds, wid, lane); S.done(cur); }
#undef PG8_SA
#undef PG8_SB
#undef PG8_STAGE
#undef PG8_LDA
#undef PG8_LDB
#undef PG8_MMA
#undef PG8_WAIT_V
#undef PG8_WAIT_L
#undef PG8_BAR
#undef PG8_SCHED
}
template <class Epi, class Sched, bool ALIGN_EPI = false, bool SP2 = false>
__device__ __forceinline__ void gemm_phase(PG8_LAS unsigned char* lds, const Gemm g, const Sched& S, const Epi& E) { gemm_phase_ld<Epi, Sched, ALIGN_EPI, SP2>(lds, g, g.K, g.K, S, E); }
}

constexpr int NB = 4, SEQ = 4096, M = NB * SEQ, D = 2048, DEPTH = 4, BW = 1024;
constexpr int IN_TOTAL = 14352, NH = 14336;
constexpr int HC_U = 0, HC_GQ = 1024, HC_GK = 1536, HC_GV = 2048, HC_GG = 3072, HC_HQ = 4096, HC_HF = 5120, HC_HI = 6144, HC_HG = 7168, HC_MG = 8192;
constexpr int GLOW_COL = 3072;
constexpr int FF = 8192;
constexpr float DN_ALPHA = 1.681792830507429f;
constexpr float LN_EPS = 1e-5f, RMS_EPS = 1e-6f;
constexpr int NPH = 10;
constexpr int NBLK = SEQ / 16;
constexpr int BND_Q2 = 0, BND_K2T = 8704, BND_GL = 16896, BND_A2 = 17408, BND_BYTES = 20480, BND_ROW = 272;
constexpr int NPAIR = SEQ / 32;
constexpr int SLOT_VT = BND_BYTES, SLOT_BYTES = BND_BYTES + 4096;

constexpr size_t MiB = 1u << 20;
constexpr size_t WS_CTL = 0, CTL_ZERO_BYTES = 1 * MiB;
constexpr size_t WS_WIN = 1 * MiB;
constexpr size_t WS_WGLU = WS_WIN + 56 * MiB;
constexpr size_t WS_WUP = WS_WGLU + 2 * MiB;
constexpr size_t WS_WOUT = WS_WUP + 12 * MiB;
constexpr size_t WS_W1 = WS_WOUT + 8 * MiB;
constexpr size_t WS_W2 = WS_W1 + 32 * MiB;
constexpr size_t WS_XB = WS_W2 + 32 * MiB;
constexpr size_t WS_Y = WS_XB + 64 * MiB;
constexpr size_t WS_BND = WS_XB;
constexpr size_t WS_H = WS_Y + 128 * MiB;
constexpr size_t WS_Z = WS_H + 448 * MiB;
constexpr size_t WS_YCAT = WS_Z + 32 * MiB;
constexpr size_t WS_MERGED = WS_YCAT + 96 * MiB;
constexpr size_t WS_VT = WS_MERGED;
constexpr size_t WS_GLOW = WS_MERGED + 64 * MiB;
constexpr size_t WS_U = WS_GLOW + 1 * MiB;
constexpr size_t WS_S5W = WS_U + 32 * MiB;
constexpr size_t WS_S5TQ = WS_S5W + 16 * MiB;
constexpr size_t WS_S5C = WS_S5TQ + 48 * MiB;
constexpr size_t WS_WGLOW = WS_S5C + 1 * MiB;
constexpr size_t WS_Y2 = WS_WGLOW + 1 * MiB;
constexpr size_t WS_ST = WS_Y2 + 128 * MiB;
constexpr size_t WS_ID = WS_ST + 1 * MiB;
constexpr size_t WS_END = WS_ID + 1 * MiB;
static_assert((size_t)48 * NPAIR * BND_BYTES <= 192 * MiB, "bundles fit XB + Y");
constexpr int CW_BAR = 4096;

constexpr int NWAVES = 8;
constexpr int RING_BYTES = 131072, LDS_BYTES = 163840, LDSCTL_OFF = LDS_BYTES - 1024, MISC_OFF = LDSCTL_OFF + 320;

#define GAS __attribute__((address_space(1)))
#define LAS __attribute__((address_space(3)))
typedef unsigned short bf16;
typedef unsigned v4u __attribute__((ext_vector_type(4)));
typedef unsigned v2u __attribute__((ext_vector_type(2)));
typedef float f32x4 __attribute__((ext_vector_type(4)));
typedef short bf16x8 __attribute__((ext_vector_type(8)));
#define LDS_WAIT() asm volatile("s_waitcnt lgkmcnt(0)" ::: "memory")
__device__ __forceinline__ unsigned f2bf(float f) { unsigned u = __builtin_bit_cast(unsigned, f); return (u + 0x7fffu + ((u >> 16) & 1u)) >> 16; }
__device__ __forceinline__ unsigned pk2(float lo, float hi) { return f2bf(lo) | (f2bf(hi) << 16); }
typedef __bf16 bfx2_t __attribute__((ext_vector_type(2)));
typedef float f32x2_t __attribute__((ext_vector_type(2)));
__device__ __forceinline__ unsigned cvtpk(float lo, float hi) { const f32x2_t v = {lo, hi}; const bfx2_t b = __builtin_convertvector(v, bfx2_t); return __builtin_bit_cast(unsigned, b); }
typedef _Float16 f16x2_t __attribute__((ext_vector_type(2)));
__device__ __forceinline__ unsigned cvtpk_h(float lo, float hi) { const f32x2_t v = {lo, hi}; const f16x2_t h = __builtin_convertvector(v, f16x2_t); return __builtin_bit_cast(unsigned, h); }
__device__ __forceinline__ f32x2_t unpk_h(unsigned w) { const f16x2_t h = __builtin_bit_cast(f16x2_t, w); return __builtin_convertvector(h, f32x2_t); }
__device__ __forceinline__ float bf2f(bf16 v) { return __uint_as_float(((unsigned)v) << 16); }
__device__ __forceinline__ float bflo(unsigned w) { return __uint_as_float(w << 16); }
__device__ __forceinline__ float bfhi(unsigned w) { return __uint_as_float(w & 0xffff0000u); }
#define DPP_ADD(v, ctrl) ((v) + __builtin_bit_cast(float, __builtin_amdgcn_update_dpp(0, __builtin_bit_cast(int, (v)), (ctrl), 0xF, 0xF, false)))
__device__ __forceinline__ float row16_sum(float v) {
    v = DPP_ADD(v, 0xB1); v = DPP_ADD(v, 0x4E); v = DPP_ADD(v, 0x141); v = DPP_ADD(v, 0x140);
    return v;
}
__device__ __forceinline__ float wave_sum(float v) {
    v = row16_sum(v);
    const int vi = __builtin_bit_cast(int, v);
    return (__builtin_bit_cast(float, __builtin_amdgcn_readlane(vi, 0)) + __builtin_bit_cast(float, __builtin_amdgcn_readlane(vi, 16))) + (__builtin_bit_cast(float, __builtin_amdgcn_readlane(vi, 32)) + __builtin_bit_cast(float, __builtin_amdgcn_readlane(vi, 48)));
}
__device__ __forceinline__ float half_sum(float v, int lane) {
    const int vi = __builtin_bit_cast(int, row16_sum(v));
    const float lo = __builtin_bit_cast(float, __builtin_amdgcn_readlane(vi, 0)) + __builtin_bit_cast(float, __builtin_amdgcn_readlane(vi, 16)), hi = __builtin_bit_cast(float, __builtin_amdgcn_readlane(vi, 32)) + __builtin_bit_cast(float, __builtin_amdgcn_readlane(vi, 48));
    return (lane & 32) ? hi : lo;
}
__device__ __forceinline__ float sigm(float x) { return __builtin_amdgcn_rcpf(1.0f + __expf(-x)); }
__device__ __forceinline__ float gelu_tanh(float x) { const float u = 0.7978845608028654f * (x + 0.044715f * x * x * x); return 0.5f * x * (1.0f + tanhf(u)); }
__device__ __forceinline__ float logsigmoidf_(float z) { return fminf(z, 0.f) - log1pf(expf(-fabsf(z))); }
__device__ __forceinline__ bf16x8 mk8(unsigned a, unsigned b, unsigned c, unsigned d) { v4u t; t.x = a; t.y = b; t.z = c; t.w = d; return __builtin_bit_cast(bf16x8, t); }
#define MFMA16(a, b, c) __builtin_amdgcn_mfma_f32_16x16x32_bf16((a), (b), (c), 0, 0, 0)
typedef short bf16x4 __attribute__((ext_vector_type(4)));
#define MFMA16K(a, b, c) __builtin_amdgcn_mfma_f32_16x16x16bf16_1k((a), (b), (c), 0, 0, 0)

#define XB_TMO      128
#define XB_XCNT(j)  (256  + 64 * (j))
#define XB_XSUB(j)  (1280 + 64 * (j))
#define XB_XGEN(j)  (2304 + 64 * (j))
#define XB_TOP      3328
#define XB_TOPGEN   3392
#define XCD_BAR_WORDS 3456
#define XB_SPIN_CAP (1u << 18)
__device__ __forceinline__ unsigned xb_ld(unsigned* p)              { return __hip_atomic_load(p, __ATOMIC_RELAXED, __HIP_MEMORY_SCOPE_AGENT); }
__device__ __forceinline__ unsigned xb_add(unsigned* p, unsigned v) { return __hip_atomic_fetch_add(p, v, __ATOMIC_RELAXED, __HIP_MEMORY_SCOPE_AGENT); }
__device__ __forceinline__ unsigned xb_xcc_id() { return (unsigned)__builtin_amdgcn_s_getreg((3 << 11) | 20) & 0xFu; }
#define XB_SPIN(cond, bar) do { unsigned _sp = 0; while (cond) { __builtin_amdgcn_s_sleep(1); \
    if ((++_sp & 255u) == 0u) { if (xb_ld(&(bar)[XB_TMO])) break; if (_sp > XB_SPIN_CAP) { atomicAdd(&(bar)[XB_TMO], 1u); break; } } } } while (0)
struct XcdBarrier { unsigned* bar; unsigned x; volatile LAS unsigned* st; };
__device__ __forceinline__ XcdBarrier xcd_barrier_post(unsigned* bar, volatile LAS unsigned* st) {
    XcdBarrier b; b.bar = bar; b.x = xb_xcc_id(); b.st = st;
    if (threadIdx.x == 0) (void)xb_add(&bar[XB_XCNT(b.x)], 1u);
    return b;
}
__device__ __forceinline__ void xcd_barrier_complete(unsigned* bar, unsigned x, unsigned& nloc, unsigned& nx) {
    const unsigned G = gridDim.x * gridDim.y * gridDim.z;
    unsigned sum, cnt, mine, sp = 0u;
    for (;;) {
        sum = 0u; cnt = 0u; mine = 0u;
#pragma unroll
        for (unsigned j = 0; j < 16; ++j) { const unsigned c = xb_ld(&bar[XB_XCNT(j)]); sum += c; cnt += (c > 0u) ? 1u : 0u; mine = (j == x) ? c : mine; }
        if (sum == G) break;
        __builtin_amdgcn_s_sleep(1);
        if ((++sp & 255u) == 0u) { if (xb_ld(&bar[XB_TMO])) break; if (sp > XB_SPIN_CAP) { atomicAdd(&bar[XB_TMO], 1u); break; } }
    }
    nloc = mine > 0u ? mine : 1u; nx = cnt > 0u ? cnt : 1u;
}
__device__ __forceinline__ void xcd_barrier(const XcdBarrier& b) {
    asm volatile("s_waitcnt vmcnt(0)" ::: "memory");
    __syncthreads();
    if (threadIdx.x == 0) {
        unsigned* bar = b.bar;
        __builtin_amdgcn_s_waitcnt(0);
        unsigned nloc = b.st[0], nx = b.st[1];
        if (nloc == 0u) { xcd_barrier_complete(bar, b.x, nloc, nx); b.st[0] = nloc; b.st[1] = nx; }
        const unsigned old = xb_add(&bar[XB_XSUB(b.x)], 1u);
        const unsigned gen = old / nloc;
        if (old + 1u == (gen + 1u) * nloc) {
            __builtin_amdgcn_fence(__ATOMIC_RELEASE, "agent");
            asm volatile("s_waitcnt vmcnt(0)" ::: "memory");
            const unsigned og = xb_add(&bar[XB_TOP], 1u);
            const unsigned tg = og / nx;
            if (og + 1u == (tg + 1u) * nx) xb_add(&bar[XB_TOPGEN], 1u);
            else XB_SPIN(xb_ld(&bar[XB_TOPGEN]) == tg, bar);
            __builtin_amdgcn_fence(__ATOMIC_ACQUIRE, "agent");
            xb_add(&bar[XB_XGEN(b.x)], 1u);
            asm volatile("s_waitcnt vmcnt(0)" ::: "memory");
        } else {
            XB_SPIN(xb_ld(&bar[XB_XGEN(b.x)]) == gen, bar);
            __builtin_amdgcn_fence(__ATOMIC_ACQUIRE, "agent");
            asm volatile("s_waitcnt vmcnt(0)" ::: "memory");
        }
    }
    __syncthreads();
}

struct Args { const float* in[25]; float* out; unsigned char* ws; int ph_lo, ph_hi, bar_idx, pad; };
enum { I_X = 0, I_WIN, I_LAMRE, I_LAMIM, I_LOGDT, I_BRE, I_BIM, I_CRE, I_CIM, I_S5D, I_WGLU, I_BGLU, I_GWG, I_GBG, I_GNW, I_LBL, I_HNW, I_WUP, I_WOUT, I_LN1G, I_LN1B, I_LN2G, I_LN2B, I_W1, I_W2 };

__device__ __forceinline__ void cvt_item(const float* src, int ld_src, int c0, bf16* dst, int ld_dst, int row_off, int koff, int nblk, int item, LAS float* scr, int lane) {
    const int kb = item / nblk, nb = item % nblk, k0 = 64 * kb, n0 = 32 * nb;
    {
        const int kr = lane >> 3, q = lane & 7; const GAS float* sp = (const GAS float*)src + (size_t)(k0 + kr) * ld_src + c0 + n0 + 4 * q;
        f32x4 v[8];
#pragma unroll
        for (int i = 0; i < 8; ++i) v[i] = *(const GAS f32x4*)(sp + (size_t)(8 * i) * ld_src);
#pragma unroll
        for (int i = 0; i < 8; ++i) *(LAS f32x4*)(scr + (8 * i + kr) * 36 + 4 * q) = v[i];
    }
    LDS_WAIT(); asm volatile("" ::: "memory");
    const int c = lane & 7;
#pragma unroll
    for (int j = 0; j < 4; ++j) { const int n = (lane >> 3) + 8 * j; const LAS float* s = scr + (8 * c) * 36 + n;
        v4u o; o.x = pk2(s[0 * 36], s[1 * 36]); o.y = pk2(s[2 * 36], s[3 * 36]); o.z = pk2(s[4 * 36], s[5 * 36]); o.w = pk2(s[6 * 36], s[7 * 36]);
        *(GAS v4u*)(dst + (size_t)(row_off + n0 + n) * ld_dst + koff + k0 + 8 * c) = o; }
    LDS_WAIT(); asm volatile("" ::: "memory");
}

__device__ __forceinline__ void ln_phase(const bf16* Y, const float* g, const float* b, float* out, bf16* xb, float* st, int gw, int NGW, int lane) {
    v4u nv[4];
    if (gw < M) { const GAS v4u* yr = (const GAS v4u*)(Y + (size_t)gw * D) + lane;
#pragma unroll
        for (int j = 0; j < 4; ++j) nv[j] = yr[64 * j]; }
    for (int m = gw; m < M; m += NGW) {
        f32x4 v[8]; float s = 0.f;
#pragma unroll
        for (int j = 0; j < 4; ++j) { const f32x2_t a = unpk_h(nv[j].x), b2 = unpk_h(nv[j].y), c = unpk_h(nv[j].z), d = unpk_h(nv[j].w); v[2 * j] = (f32x4){a.x, a.y, b2.x, b2.y}; v[2 * j + 1] = (f32x4){c.x, c.y, d.x, d.y}; }
        { const int mn = m + NGW < M ? m + NGW : m; const GAS v4u* yr = (const GAS v4u*)(Y + (size_t)mn * D) + lane;
#pragma unroll
          for (int j = 0; j < 4; ++j) nv[j] = yr[64 * j]; }
#pragma unroll
        for (int j = 0; j < 8; ++j) s += (v[j][0] + v[j][1]) + (v[j][2] + v[j][3]);
        const float mean = wave_sum(s) * (1.0f / D); float s2 = 0.f;
#pragma unroll
        for (int j = 0; j < 8; ++j) { v[j] = v[j] - mean; s2 += (v[j][0] * v[j][0] + v[j][1] * v[j][1]) + (v[j][2] * v[j][2] + v[j][3] * v[j][3]); }
        const float rstd = rsqrtf(wave_sum(s2) * (1.0f / D) + LN_EPS);
        if (out) {
            GAS f32x4* orow = (GAS f32x4*)(out + (size_t)m * D) + 2 * lane;
#pragma unroll
            for (int j = 0; j < 8; ++j) { const int c4 = 2 * lane + 128 * (j >> 1) + (j & 1); const f32x4 gg = ((const f32x4*)g)[c4], bb = ((const f32x4*)b)[c4]; orow[128 * (j >> 1) + (j & 1)] = v[j] * rstd * gg + bb; }
        } else {
            if (lane == 0) { st[2 * (size_t)m] = mean; st[2 * (size_t)m + 1] = rstd; }
            GAS v4u* o16 = (GAS v4u*)(xb + (size_t)m * D) + lane;
#pragma unroll
            for (int j = 0; j < 4; ++j) { const int c4 = 2 * lane + 128 * j; const f32x4 g0 = ((const f32x4*)g)[c4], b0 = ((const f32x4*)b)[c4], g1 = ((const f32x4*)g)[c4 + 1], b1 = ((const f32x4*)b)[c4 + 1];
                const f32x4 o0 = v[2 * j] * rstd * g0 + b0, o1 = v[2 * j + 1] * rstd * g1 + b1;
                v4u w; w.x = cvtpk(o0[0], o0[1]); w.y = cvtpk(o0[2], o0[3]); w.z = cvtpk(o1[0], o1[1]); w.w = cvtpk(o1[2], o1[3]);
                o16[64 * j] = w; }
        }
    }
}

__device__ __forceinline__ void cpow_(double revd, float lrdt, int m, float& re, float& im) {
    double a = revd * (double)m; a -= rint(a);
    const float mag = __expf(lrdt * (float)m), af = (float)a; re = mag * __builtin_amdgcn_cosf(af); im = mag * __builtin_amdgcn_sinf(af);
}
__device__ __forceinline__ void s5_build(const Args& args, int l, int g, bf16* WgT, bf16* TQ, float* S5C, LAS unsigned char* lds, int tid) {
    LAS double* angd = (LAS double*)lds;
    LAS float* lrdt = (LAS float*)(lds + 512);
    LAS float* bbr = lrdt + 64;
    LAS float* bbi = bbr + 1024;
    LAS float* car = bbi + 1024;
    LAS float* cai = car + 1024;
    LAS float* ktab = cai + 1024;
    __syncthreads();
    if (tid < 64) {
        const int p = tid;
        const float lr = fminf(args.in[I_LAMRE][(l * 64 + g) * 64 + p], -1e-4f), li = args.in[I_LAMIM][(l * 64 + g) * 64 + p];
        const float dt = expf(args.in[I_LOGDT][l * 64 + g]);
        const double rev = (double)li * (double)dt * 0.15915494309189533577;
        angd[p] = rev; lrdt[p] = lr * dt;
        float ar, ai; cpow_(rev, lr * dt, 1, ar, ai);
        const float den = lr * lr + li * li;
        const float fre = ((ar - 1.0f) * lr + ai * li) / den, fim = (ai * lr - (ar - 1.0f) * li) / den;
#pragma unroll
        for (int c = 0; c < 16; ++c) { const float br = args.in[I_BRE][((size_t)(l * 64 + g) * 64 + p) * 16 + c], bi = args.in[I_BIM][((size_t)(l * 64 + g) * 64 + p) * 16 + c];
            bbr[p * 16 + c] = fre * br - fim * bi; bbi[p * 16 + c] = fre * bi + fim * br; }
        float r16, i16, r512, i512; cpow_(rev, lr * dt, 16, r16, i16); cpow_(rev, lr * dt, 512, r512, i512);
        S5C[p] = r16; S5C[64 + p] = i16; S5C[128 + p] = r512; S5C[192 + p] = i512;
    }
    __syncthreads();
    {
        const int p = tid & 63, jj = tid >> 6;
#pragma unroll
        for (int h = 0; h < 2; ++h) { const int j = jj + 8 * h; float pr, pi; cpow_(angd[p], lrdt[p], 15 - j, pr, pi);
            unsigned wr[8], wi[8];
#pragma unroll
            for (int c = 0; c < 16; c += 2) { const float r0 = pr * bbr[p * 16 + c] - pi * bbi[p * 16 + c], i0 = pr * bbi[p * 16 + c] + pi * bbr[p * 16 + c];
                const float r1 = pr * bbr[p * 16 + c + 1] - pi * bbi[p * 16 + c + 1], i1 = pr * bbi[p * 16 + c + 1] + pi * bbr[p * 16 + c + 1];
                wr[c >> 1] = pk2(r0, r1); wi[c >> 1] = pk2(i0, i1); }
            v4u* dr = (v4u*)(WgT + (size_t)p * 256 + j * 16); v4u* di = (v4u*)(WgT + (size_t)(64 + p) * 256 + j * 16);
            v4u t; t.x = wr[0]; t.y = wr[1]; t.z = wr[2]; t.w = wr[3]; dr[0] = t; t.x = wr[4]; t.y = wr[5]; t.z = wr[6]; t.w = wr[7]; dr[1] = t;
            t.x = wi[0]; t.y = wi[1]; t.z = wi[2]; t.w = wi[3]; di[0] = t; t.x = wi[4]; t.y = wi[5]; t.z = wi[6]; t.w = wi[7]; di[1] = t; }
    }
    for (int tau = 0; tau <= 16; ++tau) {
        __syncthreads();
#pragma unroll
        for (int h = 0; h < 2; ++h) { const int e = tid + 512 * h, c = e >> 6, p = e & 63;
            float pr, pi; cpow_(angd[p], lrdt[p], tau, pr, pi);
            const float cr = args.in[I_CRE][((size_t)(l * 64 + g) * 16 + c) * 64 + p], ci = args.in[I_CIM][((size_t)(l * 64 + g) * 16 + c) * 64 + p];
            const float mr = cr * pr - ci * pi, mi = cr * pi + ci * pr;
            car[e] = mr; cai[e] = mi;
            if (tau >= 1) { const int n = (tau - 1) * 16 + c; TQ[(size_t)n * 384 + 256 + p] = (bf16)f2bf(mr); TQ[(size_t)n * 384 + 320 + p] = (bf16)f2bf(-mi); } }
        __syncthreads();
        if (tau < 16 && tid < 256) { const int c = tid >> 4, c2 = tid & 15; float s = 0.f;
            for (int p = 0; p < 64; ++p) s += car[c * 64 + p] * bbr[p * 16 + c2] - cai[c * 64 + p] * bbi[p * 16 + c2];
            ktab[tau * 256 + c * 16 + c2] = s; }
    }
    __syncthreads();
    {
        const int n = tid >> 1, i = n >> 4, c = n & 15, hf = tid & 1;
#pragma unroll
        for (int jj = 0; jj < 8; ++jj) { const int j = hf * 8 + jj; unsigned w[8];
#pragma unroll
            for (int c2 = 0; c2 < 16; c2 += 2) { float a = 0.f, b = 0.f; if (i >= j) { a = ktab[(i - j) * 256 + c * 16 + c2]; b = ktab[(i - j) * 256 + c * 16 + c2 + 1]; } w[c2 >> 1] = pk2(a, b); }
            v4u* d = (v4u*)(TQ + (size_t)n * 384 + j * 16); v4u t; t.x = w[0]; t.y = w[1]; t.z = w[2]; t.w = w[3]; d[0] = t; t.x = w[4]; t.y = w[5]; t.z = w[6]; t.w = w[7]; d[1] = t; }
    }
    __syncthreads();
}

constexpr int S5_VS = 132;
constexpr int S5_WROW = 528, S5_TROW = 784;
__device__ __forceinline__ float gelu_fast(float x) { return x * sigm(1.5957691216057308f * (x + 0.044715f * x * x * x)); }
__device__ __forceinline__ void s5_unit(const bf16* Ubg, const bf16* WgT, const bf16* TQ, const float* S5C, const float* dsk, bf16* Zbg, LAS unsigned char* lds, int tid) {
    const int lane = tid & 63, wave = __builtin_amdgcn_readfirstlane(tid >> 6), r = lane & 15, kg = lane >> 4;
    LAS float* V = (LAS float*)lds; LAS float* CAR = V + 256 * S5_VS;
    __syncthreads();
    { const unsigned char* gsrc = (const unsigned char*)WgT + (size_t)(tid >> 5) * 512 + (tid & 31) * 16; LAS unsigned char* ldst = lds + (tid >> 5) * S5_WROW + (tid & 31) * 16;
#pragma unroll
      for (int i = 0; i < 8; ++i) *(LAS v4u*)(ldst + i * 16 * S5_WROW) = *(const v4u*)(gsrc + i * 16 * 512); }
    bf16x8 ua[2][8];
#pragma unroll
    for (int mt = 0; mt < 2; ++mt)
#pragma unroll
        for (int ks = 0; ks < 8; ++ks) ua[mt][ks] = *(const bf16x8*)(Ubg + (size_t)(32 * wave + 16 * mt + r) * 256 + 32 * ks + 8 * kg);
    __syncthreads();
    {
        f32x4 acc[2][8];
#pragma unroll
        for (int mt = 0; mt < 2; ++mt)
#pragma unroll
            for (int nt = 0; nt < 8; ++nt) acc[mt][nt] = (f32x4){0.f, 0.f, 0.f, 0.f};
#pragma unroll
        for (int ks = 0; ks < 8; ++ks)
#pragma unroll
            for (int nt = 0; nt < 8; ++nt) { const bf16x8 b = *(const LAS bf16x8*)(lds + (16 * nt + r) * S5_WROW + ks * 64 + kg * 16);
#pragma unroll
                for (int mt = 0; mt < 2; ++mt) acc[mt][nt] = MFMA16(b, ua[mt][ks], acc[mt][nt]);
                if (nt == 7) __builtin_amdgcn_sched_barrier(0); }
        __syncthreads();
#pragma unroll
        for (int mt = 0; mt < 2; ++mt)
#pragma unroll
            for (int nt = 0; nt < 8; ++nt) *(LAS f32x4*)(V + (32 * wave + 16 * mt + r) * S5_VS + 16 * nt + 4 * kg) = acc[mt][nt];
    }
    bf16x8 sa[2][4];
    {
        const float a16r = S5C[lane], a16i = S5C[64 + lane], a5r = S5C[128 + lane], a5i = S5C[192 + lane];
        asm volatile("s_waitcnt lgkmcnt(0)" ::: "memory");
        float vr[32], vi[32];
#pragma unroll
        for (int q = 0; q < 32; ++q) { vr[q] = V[(32 * wave + q) * S5_VS + lane]; vi[q] = V[(32 * wave + q) * S5_VS + 64 + lane]; }
        float sr = 0.f, si = 0.f;
#pragma unroll
        for (int q = 0; q < 32; ++q) { const float tr = vr[q], ti = vi[q]; vr[q] = sr; vi[q] = si; const float nr = a16r * sr - a16i * si + tr, ni = a16r * si + a16i * sr + ti; sr = nr; si = ni; }
        CAR[wave * 128 + lane] = sr; CAR[wave * 128 + 64 + lane] = si;
        __syncthreads();
        float cr = 0.f, ci = 0.f;
        for (int w2 = 0; w2 < wave; ++w2) { const float er = CAR[w2 * 128 + lane], ei = CAR[w2 * 128 + 64 + lane]; const float nr = a5r * cr - a5i * ci + er, ni = a5r * ci + a5i * cr + ei; cr = nr; ci = ni; }
        float pr = 1.f, pi = 0.f;
        LAS bf16* SP = (LAS bf16*)lds;
#pragma unroll
        for (int q = 0; q < 32; ++q) { const float xr = vr[q] + pr * cr - pi * ci, xi = vi[q] + pr * ci + pi * cr;
            SP[(32 * wave + q) * 264 + lane] = (bf16)f2bf(xr); SP[(32 * wave + q) * 264 + 64 + lane] = (bf16)f2bf(xi);
            const float nr = pr * a16r - pi * a16i, ni = pr * a16i + pi * a16r; pr = nr; pi = ni; }
        asm volatile("s_waitcnt lgkmcnt(0)" ::: "memory");
#pragma unroll
        for (int mt = 0; mt < 2; ++mt)
#pragma unroll
            for (int k2 = 0; k2 < 4; ++k2) sa[mt][k2] = *(const LAS bf16x8*)(lds + (32 * wave + 16 * mt + r) * S5_WROW + k2 * 64 + kg * 16);
    }
    const f32x4 dv = *(const f32x4*)(dsk + 4 * kg);
#pragma unroll 1
    for (int nh = 0; nh < 2; ++nh) {
        asm volatile("s_waitcnt lgkmcnt(0)" ::: "memory");
        __syncthreads();
        { const unsigned char* gsrc = (const unsigned char*)TQ + (size_t)(128 * nh + (tid >> 2)) * 768 + (tid & 3) * 192; LAS unsigned char* ldst = lds + (tid >> 2) * S5_TROW + (tid & 3) * 192;
#pragma unroll
          for (int i = 0; i < 12; ++i) *(LAS v4u*)(ldst + i * 16) = *(const v4u*)(gsrc + i * 16); }
        __syncthreads();
        f32x4 acc[2][8];
#pragma unroll
        for (int mt = 0; mt < 2; ++mt)
#pragma unroll
            for (int nt = 0; nt < 8; ++nt) acc[mt][nt] = (f32x4){0.f, 0.f, 0.f, 0.f};
#pragma unroll
        for (int ks = 0; ks < 12; ++ks)
#pragma unroll
            for (int nt = 0; nt < 8; ++nt) { const bf16x8 b = *(const LAS bf16x8*)(lds + (16 * nt + r) * S5_TROW + ks * 64 + kg * 16);
#pragma unroll
                for (int mt = 0; mt < 2; ++mt) acc[mt][nt] = MFMA16(b, ks < 8 ? ua[mt][ks < 8 ? ks : 0] : sa[mt][ks < 8 ? 0 : ks - 8], acc[mt][nt]);
                if (nt == 7) __builtin_amdgcn_sched_barrier(0); }
#pragma unroll
        for (int mt = 0; mt < 2; ++mt)
#pragma unroll
            for (int nt = 0; nt < 8; ++nt) { const int i = 8 * nh + nt, kb = 32 * wave + 16 * mt + r, s = 16 * kb + i;
                const v2u uu = *(const v2u*)(Ubg + (size_t)s * 16 + 4 * kg);
                const f32x4 a = acc[mt][nt];
                const float y0 = a[0] + dv[0] * bflo(uu.x), y1 = a[1] + dv[1] * bfhi(uu.x), y2 = a[2] + dv[2] * bflo(uu.y), y3 = a[3] + dv[3] * bfhi(uu.y);
                v2u o; o.x = cvtpk(gelu_fast(y0), gelu_fast(y1)); o.y = cvtpk(gelu_fast(y2), gelu_fast(y3));
                *(v2u*)(Zbg + (size_t)s * BW + 4 * kg) = o; }
    }
    __syncthreads();
}

__device__ __forceinline__ void glow_tile(const bf16* XB, const bf16* WglowT, float* GLOW, int row0, int lane) {
    const int r = lane & 15, kg = lane >> 4;
    f32x4 acc = (f32x4){0.f, 0.f, 0.f, 0.f};
#pragma unroll 16
    for (int ks = 0; ks < D / 32; ++ks) {
        const bf16x8 a = *(const bf16x8*)(XB + (size_t)(row0 + r) * D + 32 * ks + 8 * kg);
        const bf16x8 b = *(const bf16x8*)(WglowT + (size_t)r * D + 32 * ks + 8 * kg);
        acc = MFMA16(a, b, acc);
    }
#pragma unroll
    for (int j = 0; j < 4; ++j) GLOW[(size_t)(row0 + 4 * kg + j) * 16 + r] = acc[j];
}

__device__ __forceinline__ int kperm(int kk) { const int o = kk & 31; return (kk & ~31) + 8 * ((o >> 2) & 3) + 4 * (o >> 4) + (o & 3); }

constexpr int PRP_INB = 36864, PRP_Q = 0, PRP_K = 16384, PRP_G = 32768, PRP_OUT = 2 * PRP_INB, PRP_KD = PRP_OUT + 2 * BND_BYTES, PRP_QU = PRP_KD + 4 * 16 * BND_ROW, PRP_GLX = PRP_QU + 2 * 16 * BND_ROW;
__device__ __forceinline__ void prep_dma(int u, int p, const bf16* H, const float* GLOW, LAS unsigned char* lds, int tid) {
    const int bhx = u >> 6, grp = u & 63; const bool gla = bhx < 16;
    const int b = gla ? (bhx >> 2) : ((bhx - 16) >> 3), h = gla ? (bhx & 3) : ((bhx - 16) & 7);
    const size_t row0 = (size_t)b * SEQ + (size_t)grp * 64;
    const int qcol = gla ? (HC_GQ + h * 128) : (HC_HQ + h * 128), kcol = gla ? (HC_GK + h * 128) : (HC_HF + h * 128);
    const int lane = tid & 63, w = __builtin_amdgcn_readfirstlane(tid >> 6), rl = lane >> 3, c8 = lane & 7;
    const bf16* hq = H + (row0 + 8 * w + rl) * NH;
    LAS unsigned char* dst = lds + p * PRP_INB;
#pragma unroll
    for (int j = 0; j < 2; ++j) {
        __builtin_amdgcn_global_load_lds((const unsigned*)(hq + qcol + (c8 + 8 * j) * 8), (LAS unsigned*)(dst + PRP_Q + j * 8192 + w * 1024), 16, 0, 0);
        __builtin_amdgcn_global_load_lds((const unsigned*)(hq + kcol + (c8 + 8 * j) * 8), (LAS unsigned*)(dst + PRP_K + j * 8192 + w * 1024), 16, 0, 0); }
    if (w < 4) __builtin_amdgcn_global_load_lds((const unsigned*)(GLOW + (row0 + 16 * w + (lane >> 2)) * 16 + (lane & 3) * 4), (LAS unsigned*)(dst + PRP_G + w * 1024), 16, 0, 0);
}
__device__ __forceinline__ void prep_unit(const Args& args, int l, int u, int unext, int p, const bf16* H, const float* GLOW, unsigned char* BND, LAS unsigned char* lds, int tid) {
    const int bhx = u >> 6, grp = u & 63, kk = tid & 127, bl = tid >> 7;
    const bool gla = bhx < 16;
    const int h = gla ? (bhx & 3) : ((bhx - 16) & 7);
    asm volatile("s_waitcnt vmcnt(0)" ::: "memory");
    __syncthreads();
    if (unext < 48 * 64) prep_dma(unext, p ^ 1, H, GLOW, lds, tid);
    const LAS unsigned char* inb = lds + p * PRP_INB;
    float q[16], k[16], G[16];
    const LAS bf16* sq = (const LAS bf16*)(inb + PRP_Q + (kk >> 6) * 8192) + (16 * bl) * 64 + (kk & 63); const LAS bf16* sk = (const LAS bf16*)(inb + PRP_K + (kk >> 6) * 8192) + (16 * bl) * 64 + (kk & 63);
    if (gla) {
        float wg[16];
#pragma unroll
        for (int r = 0; r < 16; ++r) wg[r] = args.in[I_GWG][((size_t)l * 16 + r) * 512 + h * 128 + kk];
        const float bg = args.in[I_GBG][l * 512 + h * 128 + kk];
        float run = 0.f;
#pragma unroll
        for (int i = 0; i < 16; ++i) { const LAS f32x4* gp = (const LAS f32x4*)(inb + PRP_G + (16 * bl + i) * 64); float z = bg;
#pragma unroll
            for (int r4 = 0; r4 < 4; ++r4) { const f32x4 gv = gp[r4]; z += gv[0] * wg[4 * r4] + gv[1] * wg[4 * r4 + 1] + gv[2] * wg[4 * r4 + 2] + gv[3] * wg[4 * r4 + 3]; }
            const float ls = fminf(z, 0.f) - __logf(1.0f + __expf(-fabsf(z)));
            run += fmaxf(ls * (1.0f / 16.0f), -100.f); G[i] = run;
            q[i] = bf2f(sq[i * 64]) * 0.08838834764831845f; k[i] = bf2f(sk[i * 64]); }
    } else {
        float lbv;
        { float lg[4], mx = -1e30f;
#pragma unroll
          for (int t = 0; t < 4; ++t) { lg[t] = args.in[I_LBL][t * 1024 + h * 128 + kk]; mx = fmaxf(mx, lg[t]); }
          float e[4], se = 0.f;
#pragma unroll
          for (int t = 0; t < 4; ++t) { e[t] = __expf(lg[t] - mx); se += e[t]; }
          float cs = 0.f;
#pragma unroll
          for (int t = 1; t < 4; ++t) if (t <= l) cs += e[t] / se;
          lbv = cs; }
        float run = 0.f;
#pragma unroll
        for (int i = 0; i < 16; ++i) { const float fl = bf2f(sk[i * 64]); const float f = lbv + (1.0f - lbv) * sigm(fl);
            run += fmaxf(__logf(f), -100.f); G[i] = run; k[i] = 1.0f - f;
            const float qv = bf2f(sq[i * 64]); q[i] = qv * sigm(qv); }
    }
    const int pr = bl >> 1, hf = bl & 1;
    LAS unsigned char* img = lds + PRP_OUT + pr * BND_BYTES; LAS unsigned char* kds = lds + PRP_KD + bl * (16 * BND_ROW); LAS unsigned char* qus = lds + PRP_QU + pr * (16 * BND_ROW);
    LAS float* glx = (LAS float*)(lds + PRP_GLX);
    const int pos = kperm(kk);
    const float Gl = G[15], GLs = __expf(Gl);
    glx[bl * 128 + kk] = GLs;
    __syncthreads();
    const float GLp = glx[(bl ^ 1) * 128 + kk];
    unsigned kh[8];
#pragma unroll
    for (int i = 0; i < 16; i += 2) {
        const float E0 = __expf(fmaxf(G[i], -80.f)), E1 = __expf(fmaxf(G[i + 1], -80.f));
        const float R0 = __builtin_amdgcn_rcpf(E0), R1 = __builtin_amdgcn_rcpf(E1);
        const float q0 = q[i] * E0, q1 = q[i + 1] * E1;
        *(LAS bf16*)(img + BND_Q2 + (16 * hf + i) * BND_ROW + pos * 2) = (bf16)f2bf(hf ? q0 * GLp : q0);
        *(LAS bf16*)(img + BND_Q2 + (16 * hf + i + 1) * BND_ROW + pos * 2) = (bf16)f2bf(hf ? q1 * GLp : q1);
        if (hf) { *(LAS bf16*)(qus + i * BND_ROW + pos * 2) = (bf16)f2bf(q0); *(LAS bf16*)(qus + (i + 1) * BND_ROW + pos * 2) = (bf16)f2bf(q1); }
        *(LAS bf16*)(kds + i * BND_ROW + pos * 2) = (bf16)f2bf(k[i] * R0);
        *(LAS bf16*)(kds + (i + 1) * BND_ROW + pos * 2) = (bf16)f2bf(k[i + 1] * R1);
        const float h0 = k[i] * __expf(Gl - G[i]), h1 = k[i + 1] * __expf(Gl - G[i + 1]);
        kh[i >> 1] = hf ? pk2(h0, h1) : pk2(h0 * GLp, h1 * GLp);
    }
    { LAS v4u* d = (LAS v4u*)(img + BND_K2T + kk * 64 + hf * 32); v4u t; t.x = kh[0]; t.y = kh[1]; t.z = kh[2]; t.w = kh[3]; d[0] = t; t.x = kh[4]; t.y = kh[5]; t.z = kh[6]; t.w = kh[7]; d[1] = t; }
    if (hf == 0) *(LAS float*)(img + BND_GL + kk * 4) = GLs * GLp;
    { unsigned z0 = 0u; asm volatile("" : "+v"(z0));
      if (kk < 16) *(LAS v4u*)(img + BND_Q2 + (16 * hf + kk) * BND_ROW + 256) = (v4u){z0, z0, z0, z0};
      if (hf == 0 && kk < 16) { *(LAS v4u*)(img + BND_A2 + kk * 64 + 32) = (v4u){z0, z0, z0, z0}; *(LAS v4u*)(img + BND_A2 + kk * 64 + 48) = (v4u){z0, z0, z0, z0}; }
      if (hf == 1 && kk < 64) *(LAS v4u*)(img + BND_A2 + 2048 + kk * 16) = (v4u){z0, z0, z0, z0}; }
    __syncthreads();
    if (tid < 384) {
        const int w = tid >> 6, lane = tid & 63, r = lane & 15, kg = lane >> 4, p2 = w / 3, wh = w - 3 * p2;
        LAS unsigned char* im = lds + PRP_OUT + p2 * BND_BYTES;
        const LAS unsigned char* qsrc = wh == 0 ? im + BND_Q2 : wh == 1 ? im + BND_Q2 + 16 * BND_ROW : lds + PRP_QU + p2 * (16 * BND_ROW);
        const LAS unsigned char* kd = lds + PRP_KD + (2 * p2 + (wh == 2 ? 1 : 0)) * (16 * BND_ROW);
        f32x4 At = (f32x4){0.f, 0.f, 0.f, 0.f}, At2 = (f32x4){0.f, 0.f, 0.f, 0.f};
#pragma unroll
        for (int ks = 0; ks < 4; ++ks) { const bf16x8 qf = *(const LAS bf16x8*)(qsrc + r * BND_ROW + ks * 64 + kg * 16), kf = *(const LAS bf16x8*)(kd + r * BND_ROW + ks * 64 + kg * 16);
            if (ks & 1) At2 = MFMA16(kf, qf, At2); else At = MFMA16(kf, qf, At); }
        At = At + At2;
        if (wh != 1) {
#pragma unroll
            for (int j = 0; j < 4; ++j) if (4 * kg + j > r) At[j] = 0.f; }
        v2u ab; ab.x = cvtpk(At[0], At[1]); ab.y = cvtpk(At[2], At[3]);
        *(LAS v2u*)(im + BND_A2 + ((wh == 0 ? 0 : 16) + r) * 64 + ((wh == 2 ? 16 : 0) + 4 * kg) * 2) = ab;
    }
    __syncthreads();
    {
        unsigned char* dst = BND + ((size_t)bhx * NPAIR + grp * 2) * BND_BYTES;
#pragma unroll
        for (int i = 0; i < 2 * BND_BYTES / 16 / 512; ++i) { const int c = tid + 512 * i; *(GAS v4u*)(dst + c * 16) = *(const LAS v4u*)(lds + PRP_OUT + c * 16); }
    }
}

__device__ __forceinline__ void rec_unit(int u, const unsigned char* BND, const bf16* H, bf16* YCAT, LAS unsigned char* lds, int tid) {
    const int lane = tid & 63, wave = __builtin_amdgcn_readfirstlane(tid >> 6), r = lane & 15, kg = lane >> 4;
    const bool gla = u < 64;
    const int bh = gla ? (u >> 2) : ((u - 64) >> 1), dvg = gla ? (u & 3) : ((u - 64) & 1), bhx = gla ? bh : 16 + bh;
    const int b = gla ? (bh >> 2) : (bh >> 3), h = gla ? (bh & 3) : (bh & 7);
    const unsigned char* bnd = BND + (size_t)bhx * NPAIR * BND_BYTES;
    const bf16* vsrc = H + (size_t)b * SEQ * NH + (gla ? HC_GV + h * 256 : HC_HI + h * 128) + dvg * 64;
    const int ocol = (gla ? BW + h * 256 : 2 * BW + h * 128) + dvg * 64;
#define REC_BAR() do { asm volatile("" ::: "memory"); __builtin_amdgcn_s_barrier(); asm volatile("" ::: "memory"); } while (0)
    __syncthreads();
    if (wave >= 4) {
        const int lw = wave - 4;
        constexpr int RDEPTH = 4;
        const GAS unsigned char* gsrc[6]; int lofs[6]; size_t gstep[6];
#pragma unroll
        for (int q = 0; q < 6; ++q) { const int p = lw + 4 * q; lofs[q] = p * 1024 + lane * 16;
            gsrc[q] = (const GAS unsigned char*)(p < 20 ? bnd + p * 1024 + lane * 16 : (const unsigned char*)(vsrc + (size_t)(8 * (p - 20) + (lane >> 3)) * NH) + (lane & 7) * 16); gstep[q] = p < 20 ? (size_t)BND_BYTES : (size_t)32 * NH * 2; }
        v4u buf[RDEPTH][6];
#define REC_LOAD(j, pr_) do { const int pq = (pr_) < NPAIR ? (pr_) : NPAIR - 1; _Pragma("unroll") for (int q = 0; q < 6; ++q) { const GAS unsigned char* p_ = gsrc[q] + (size_t)pq * gstep[q]; \
            asm volatile("global_load_dwordx4 %0, %1, off" : "=v"(buf[j][q]) : "v"(p_) : "memory"); } } while (0)
#define REC_WRITE(j, pr_) do { asm volatile("s_waitcnt vmcnt(18)" : "+v"(buf[j][0]), "+v"(buf[j][1]), "+v"(buf[j][2]), "+v"(buf[j][3]), "+v"(buf[j][4]), "+v"(buf[j][5]) :: "memory"); \
            LAS unsigned char* slot = lds + ((pr_) % 3) * SLOT_BYTES; _Pragma("unroll") for (int q = 0; q < 6; ++q) *(LAS v4u*)(slot + lofs[q]) = buf[j][q]; } while (0)
#pragma unroll
        for (int j = 0; j < RDEPTH; ++j) REC_LOAD(j, j);
        REC_WRITE(0, 0); REC_LOAD(0, RDEPTH); REC_WRITE(1, 1); REC_LOAD(1, RDEPTH + 1);
        asm volatile("s_waitcnt lgkmcnt(0)" ::: "memory");
        REC_BAR();
        for (int n = 0; n < NPAIR; n += RDEPTH) {
#pragma unroll
            for (int j = 0; j < RDEPTH; ++j) { const int m = n + j;
                REC_WRITE((j + 2) % RDEPTH, m + 2); REC_LOAD((j + 2) % RDEPTH, m + 2 + RDEPTH);
                asm volatile("s_waitcnt lgkmcnt(0)" ::: "memory");
                REC_BAR(); }
        }
        asm volatile("s_waitcnt vmcnt(0)" : "+v"(buf[0][0]), "+v"(buf[0][1]), "+v"(buf[0][2]), "+v"(buf[0][3]), "+v"(buf[0][4]), "+v"(buf[0][5]), "+v"(buf[1][0]), "+v"(buf[1][1]), "+v"(buf[1][2]), "+v"(buf[1][3]), "+v"(buf[1][4]), "+v"(buf[1][5]),
                                            "+v"(buf[2][0]), "+v"(buf[2][1]), "+v"(buf[2][2]), "+v"(buf[2][3]), "+v"(buf[2][4]), "+v"(buf[2][5]), "+v"(buf[3][0]), "+v"(buf[3][1]), "+v"(buf[3][2]), "+v"(buf[3][3]), "+v"(buf[3][4]), "+v"(buf[3][5]) :: "memory");
#undef REC_LOAD
#undef REC_WRITE
    } else {
        f32x4 S[8];
#pragma unroll
        for (int kt = 0; kt < 8; ++kt) S[kt] = (f32x4){0.f, 0.f, 0.f, 0.f};
        REC_BAR();
        for (int n = 0; n < NPAIR; ++n) {
            const LAS unsigned char* base = lds + (n % 3) * SLOT_BYTES;
            bf16x8 qf[2][4], af[2], kf[8]; f32x4 gl[8];
#pragma unroll
            for (int tt = 0; tt < 2; ++tt) {
#pragma unroll
                for (int ks = 0; ks < 4; ++ks) qf[tt][ks] = *(const LAS bf16x8*)(base + BND_Q2 + (16 * tt + r) * BND_ROW + ks * 64 + kg * 16);
                af[tt] = *(const LAS bf16x8*)(base + BND_A2 + (16 * tt + r) * 64 + kg * 16); }
            unsigned vw[4];
            { const LAS bf16* vp = (const LAS bf16*)(base + SLOT_VT) + (8 * kg) * 64 + 16 * wave + r;
#pragma unroll
              for (int j = 0; j < 4; ++j) vw[j] = (unsigned)vp[(2 * j) * 64] | ((unsigned)vp[(2 * j + 1) * 64] << 16); }
            const bf16x8 vf = mk8(vw[0], vw[1], vw[2], vw[3]);
#pragma unroll
            for (int kt = 0; kt < 8; ++kt) { kf[kt] = *(const LAS bf16x8*)(base + BND_K2T + (16 * kt + r) * 64 + kg * 16); gl[kt] = *(const LAS f32x4*)(base + BND_GL + (16 * kt + 4 * kg) * 4); }
            bf16x8 sf[4];
#pragma unroll
            for (int ks = 0; ks < 4; ++ks) { const f32x4 s0 = S[2 * ks], s1 = S[2 * ks + 1]; sf[ks] = mk8(cvtpk(s0[0], s0[1]), cvtpk(s0[2], s0[3]), cvtpk(s1[0], s1[1]), cvtpk(s1[2], s1[3])); }
            f32x4 o0 = MFMA16(vf, af[0], ((f32x4){0.f, 0.f, 0.f, 0.f})), o1 = MFMA16(vf, af[1], ((f32x4){0.f, 0.f, 0.f, 0.f}));
#pragma unroll
            for (int ks = 0; ks < 4; ++ks) { o0 = MFMA16(sf[ks], qf[0][ks], o0); o1 = MFMA16(sf[ks], qf[1][ks], o1); }
#pragma unroll
            for (int kt = 0; kt < 8; ++kt) S[kt] = MFMA16(kf[kt], vf, S[kt] * gl[kt]);
            { GAS bf16* op = (GAS bf16*)(YCAT + ((size_t)b * SEQ + (size_t)n * 32 + r) * (3 * BW) + ocol + 16 * wave + 4 * kg);
              v2u w; w.x = cvtpk(o0[0], o0[1]); w.y = cvtpk(o0[2], o0[3]); *(GAS v2u*)op = w;
              w.x = cvtpk(o1[0], o1[1]); w.y = cvtpk(o1[2], o1[3]); *(GAS v2u*)(op + (size_t)16 * (3 * BW)) = w; }
            asm volatile("s_waitcnt lgkmcnt(0)" ::: "memory");
            REC_BAR();
        }
    }
    __syncthreads();
#undef REC_BAR
}

__device__ __forceinline__ void post_rows(const Args& args, int l, const bf16* H, bf16* YCAT, int gw, int NGW, int lane) {
    const f32x4 nwg = *(const f32x4*)(args.in[I_GNW] + l * 256 + 4 * lane);
    for (int t0 = gw; t0 < M * 4; t0 += 4 * NGW) {
        v2u ov[4], gv[4]; GAS bf16* yp[4];
#pragma unroll
        for (int j = 0; j < 4; ++j) { const int t = t0 + j * NGW < M * 4 ? t0 + j * NGW : t0; const int row = t >> 2, hh = t & 3;
            yp[j] = (GAS bf16*)(YCAT + (size_t)row * (3 * BW) + BW + hh * 256 + 4 * lane);
            ov[j] = *(const GAS v2u*)yp[j]; gv[j] = *(const GAS v2u*)(H + (size_t)row * NH + HC_GG + hh * 256 + 4 * lane); }
#pragma unroll
        for (int j = 0; j < 4; ++j) {
            const float o0 = bflo(ov[j].x), o1 = bfhi(ov[j].x), o2 = bflo(ov[j].y), o3 = bfhi(ov[j].y);
            const float rstd = rsqrtf(wave_sum(o0 * o0 + o1 * o1 + o2 * o2 + o3 * o3) * (1.0f / 256.0f) + RMS_EPS);
            const float g0 = bflo(gv[j].x), g1 = bfhi(gv[j].x), g2 = bflo(gv[j].y), g3 = bfhi(gv[j].y);
            v2u w; w.x = cvtpk(o0 * rstd * nwg[0] * (g0 * sigm(g0)), o1 * rstd * nwg[1] * (g1 * sigm(g1))); w.y = cvtpk(o2 * rstd * nwg[2] * (g2 * sigm(g2)), o3 * rstd * nwg[3] * (g3 * sigm(g3)));
            if (t0 + j * NGW < M * 4) *(GAS v2u*)yp[j] = w; }
    }
    const f32x4 nwh = *(const f32x4*)(args.in[I_HNW] + l * 128 + 4 * (lane & 31));
    for (int t0 = gw; t0 < M * 4; t0 += 4 * NGW) {
        v2u ov[4], gv[4]; GAS bf16* yp[4];
#pragma unroll
        for (int j = 0; j < 4; ++j) { const int t = t0 + j * NGW < M * 4 ? t0 + j * NGW : t0; const int row = t >> 2, hp = t & 3;
            yp[j] = (GAS bf16*)(YCAT + (size_t)row * (3 * BW) + 2 * BW + hp * 256 + 4 * lane);
            ov[j] = *(const GAS v2u*)yp[j]; gv[j] = *(const GAS v2u*)(H + (size_t)row * NH + HC_HG + hp * 256 + 4 * lane); }
#pragma unroll
        for (int j = 0; j < 4; ++j) {
            const float o0 = bflo(ov[j].x) * sigm(bflo(gv[j].x)), o1 = bfhi(ov[j].x) * sigm(bfhi(gv[j].x)), o2 = bflo(ov[j].y) * sigm(bflo(gv[j].y)), o3 = bfhi(ov[j].y) * sigm(bfhi(gv[j].y));
            const float rstd = rsqrtf(half_sum((o0 * o0 + o1 * o1) + (o2 * o2 + o3 * o3), lane) * (1.0f / 128.0f) + RMS_EPS);
            v2u w; w.x = cvtpk(o0 * rstd * nwh[0], o1 * rstd * nwh[1]); w.y = cvtpk(o2 * rstd * nwh[2], o3 * rstd * nwh[3]);
            if (t0 + j * NGW < M * 4) *(GAS v2u*)yp[j] = w; }
    }
}

__global__ void __launch_bounds__(NWAVES * 64, 2) mega_fwd(Args args) {
    extern __shared__ __attribute__((aligned(16))) unsigned char lds_raw[];
    LAS unsigned char* lds = (LAS unsigned char*)lds_raw;
    volatile LAS unsigned* MISC = (volatile LAS unsigned*)(lds + MISC_OFF);
    const int G = gridDim.x, bid = blockIdx.x;
#define FRESH_IDS() int tid = threadIdx.x; asm volatile("" : "+v"(tid)); const int lane = tid & 63, wave = __builtin_amdgcn_readfirstlane(tid >> 6), gw = bid * NWAVES + wave, NGW = G * NWAVES; (void)lane; (void)gw; (void)NGW
    unsigned* ctl = (unsigned*)(args.ws + WS_CTL);
    for (int u = threadIdx.x; u < (LDS_BYTES - LDSCTL_OFF) / 4; u += NWAVES * 64) ((LAS unsigned*)(lds + LDSCTL_OFF))[u] = 0u;
    __syncthreads();
    const int lo = args.ph_lo, hi = args.ph_hi;
    const bool use_bar = (hi - lo) > 1;
    unsigned* barw = ctl + CW_BAR + args.bar_idx * XCD_BAR_WORDS;
    XcdBarrier bar; bar.bar = barw; bar.x = 0; bar.st = nullptr;
    if (use_bar) bar = xcd_barrier_post(barw, MISC + 8);
#ifndef PHMASK
#define PHMASK 0x3ff
#endif
#define IN(k) (((PHMASK >> ((k) % NPH)) & 1) && lo <= (k) && (k) < hi)
#define SEAM(k) do { if (lo <= (k) && (k) + 1 < hi) xcd_barrier(bar); } while (0)
#ifndef REP_PH
#define REP_PH -1
#endif
#ifndef REP_N
#define REP_N 1
#endif
#define RPT(k) for (int rep_ = 0; rep_ < ((k) == REP_PH ? 1 + REP_N : 1); ++rep_)

#define PTRS() unsigned char* ws = args.ws; asm volatile("" : "+s"(ws)); bf16* WinT = (bf16*)(ws + WS_WIN); bf16* WgluT = (bf16*)(ws + WS_WGLU); bf16* WupT = (bf16*)(ws + WS_WUP); bf16* WoutT = (bf16*)(ws + WS_WOUT); bf16* W1T = (bf16*)(ws + WS_W1); bf16* W2T = (bf16*)(ws + WS_W2); bf16* XB = (bf16*)(ws + WS_XB); bf16* Y = (bf16*)(ws + WS_Y); bf16* H = (bf16*)(ws + WS_H); bf16* HID = (bf16*)(ws + WS_H); bf16* Z = (bf16*)(ws + WS_Z); bf16* YCAT = (bf16*)(ws + WS_YCAT); bf16* MERGED = (bf16*)(ws + WS_MERGED); bf16* UU = (bf16*)(ws + WS_U); bf16* S5W = (bf16*)(ws + WS_S5W); bf16* S5TQ = (bf16*)(ws + WS_S5TQ); float* S5C = (float*)(ws + WS_S5C); bf16* WglowT = (bf16*)(ws + WS_WGLOW); float* GLOW = (float*)(ws + WS_GLOW); unsigned char* BND = ws + WS_BND; bf16* VT = (bf16*)(ws + WS_VT); bf16* Y2 = (bf16*)(ws + WS_Y2); float* ST1 = (float*)(ws + WS_ST); float* ST2 = ST1 + 2 * M; float* ST0 = (float*)(ws + WS_ID); (void)WinT; (void)WgluT; (void)WupT; (void)WoutT; (void)W1T; (void)W2T; (void)XB; (void)Y; (void)H; (void)HID; (void)Z; (void)YCAT; (void)MERGED; (void)UU; (void)S5W; (void)S5TQ; (void)S5C; (void)WglowT; (void)GLOW; (void)BND; (void)VT; (void)Y2; (void)ST1; (void)ST2; (void)ST0;

    for (int l = 0; l < DEPTH; ++l) {
        const int P = l * NPH;
        RPT(0) if (IN(P + 0)) {
            PTRS(); FRESH_IDS();
            if (l > 0) ln_phase(Y2, args.in[I_LN2G] + (size_t)(l - 1) * D, args.in[I_LN2B] + (size_t)(l - 1) * D, nullptr, XB, ST2, gw, NGW, lane);
            if (l == 0) for (int lg = bid; lg < DEPTH * 64; lg += G) s5_build(args, lg >> 6, lg & 63, S5W + (size_t)lg * 128 * 256, S5TQ + (size_t)lg * 256 * 384, S5C + (size_t)lg * 256, lds, tid);
            __syncthreads();
            LAS float* scr = (LAS float*)(lds + wave * 16384);
            const float* w_in = args.in[I_WIN] + (size_t)l * D * IN_TOTAL;
            const float* w_glu = args.in[I_WGLU] + (size_t)l * BW * BW;
            const float* w_up = args.in[I_WUP] + (size_t)l * 3 * BW * D;
            const float* w_out = args.in[I_WOUT] + (size_t)l * D * D;
            const float* w1 = args.in[I_W1] + (size_t)l * D * FF;
            const float* w2 = args.in[I_W2] + (size_t)l * FF * D;
            constexpr int I_A = (D / 64) * (3072 / 32), I_B = (D / 64) * ((NH - 3072) / 32), I_G = (BW / 64) * (BW / 32), I_U = (BW / 64) * (D / 32), I_O = (D / 64) * (D / 32), I_1 = (D / 64) * (FF / 32), I_2 = (FF / 64) * (D / 32), I_L = D / 64;
            constexpr int NITEMS = I_A + I_B + I_G + 3 * I_U + I_O + I_1 + I_2 + I_L;
            for (int it = gw; it < NITEMS; it += NGW) {
                int r = it;
                if (r < I_A) { cvt_item(w_in, IN_TOTAL, 0, WinT, D, 0, 0, 3072 / 32, r, scr, lane); continue; } r -= I_A;
                if (r < I_B) { cvt_item(w_in, IN_TOTAL, 3072 + 16, WinT, D, 3072, 0, (NH - 3072) / 32, r, scr, lane); continue; } r -= I_B;
                if (r < I_G) { cvt_item(w_glu, BW, 0, WgluT, BW, 0, 0, BW / 32, r, scr, lane); continue; } r -= I_G;
                if (r < 3 * I_U) { const int b = r / I_U; cvt_item(w_up + (size_t)b * BW * D, D, 0, WupT, 3 * BW, 0, b * BW, D / 32, r - b * I_U, scr, lane); continue; } r -= 3 * I_U;
                if (r < I_O) { cvt_item(w_out, D, 0, WoutT, D, 0, 0, D / 32, r, scr, lane); continue; } r -= I_O;
                if (r < I_1) { cvt_item(w1, FF, 0, W1T, D, 0, 0, FF / 32, r, scr, lane); continue; } r -= I_1;
                if (r < I_2) { cvt_item(w2, D, 0, W2T, FF, 0, 0, D / 32, r, scr, lane); continue; } r -= I_2;
                cvt_item(w_in, IN_TOTAL, GLOW_COL, WglowT, D, 0, 0, 1, r, scr, lane);
            }
            if (l == 0) {
                for (int i = bid * 512 + tid; i < 2 * M + 2 * D + DEPTH * 4 * D; i += G * 512) {
                    float v;
                    if (i < 2 * M) v = (float)(i & 1); else if (i < 2 * M + D) v = 1.0f; else if (i < 2 * M + 2 * D) v = 0.0f;
                    else { const int e = i - 2 * M - 2 * D, ll = e / (4 * D), w = (e / D) & 3, c = e % D; const float a0 = args.in[I_LN1G][ll * D + c], a1 = args.in[I_LN1B][ll * D + c], a2 = args.in[I_LN2G][ll * D + c], a3 = args.in[I_LN2B][ll * D + c];
                           v = w == 0 ? a0 : w == 1 ? a1 : w == 2 ? a2 : a3; }
                    ST0[i] = v; }
                const f32x4* xs = (const f32x4*)args.in[I_X]; unsigned long long* xd = (unsigned long long*)XB;
                unsigned long long* xh = (unsigned long long*)Y2;
                for (size_t i = (size_t)bid * 512 + tid; i < (size_t)M * D / 4; i += (size_t)G * 512) { const f32x4 v = xs[i]; xd[i] = (unsigned long long)pk2(v[0], v[1]) | ((unsigned long long)pk2(v[2], v[3]) << 32); xh[i] = (unsigned long long)cvtpk_h(v[0], v[1]) | ((unsigned long long)cvtpk_h(v[2], v[3]) << 32); }
            }
        }
        SEAM(P + 0);
        RPT(1) if (IN(P + 1)) {
            PTRS();
            { pg8::Gemm g{XB, WinT, M, NH, D}; pg8::StaticOrder S; S.init(M, NH, G, bid);
              pg8::EpiH E{H, NH, UU};
              pg8::gemm_phase<pg8::EpiH, pg8::StaticOrder, true, true>(lds, g, S, E); }
            FRESH_IDS();
            if (wave < 4) for (int gq = bid; gq < M / 64; gq += G) glow_tile(XB, WglowT, GLOW, gq * 64 + 16 * wave, lane);
        }
        SEAM(P + 1);
        RPT(2) if (IN(P + 2)) {
            PTRS(); FRESH_IDS();
            if (bid < 48 * 64) prep_dma(bid, 0, H, GLOW, lds, tid);
            { int p = 0; for (int u = bid; u < 48 * 64; u += G, p ^= 1) prep_unit(args, l, u, u + G, p, H, GLOW, BND, lds, tid); }
            __syncthreads();
        }
        SEAM(P + 2);
        RPT(3) if (IN(P + 3)) {
            PTRS(); FRESH_IDS();
            const int nrec = G >= 256 ? 128 : G / 2;
#ifndef REP_REC
#define REP_REC 0
#endif
            if (bid < nrec) { for (int rr_ = 0; rr_ <= REP_REC; ++rr_) for (int v = bid; v < 128; v += nrec) {
                    const int x = v & 7, sl = v >> 3; const int u = sl < 8 ? (2 * x + (sl >> 2)) * 4 + (sl & 3) : 64 + (4 * x + ((sl - 8) >> 1)) * 2 + ((sl - 8) & 1);
                    rec_unit(u, BND, H, YCAT, lds, tid); } }
#ifndef REP_S5
#define REP_S5 0
#endif
            else { for (int rs_ = 0; rs_ <= REP_S5; ++rs_) for (int u = bid - nrec; u < 256; u += G - nrec) { const int b = u >> 6, g = u & 63;
                    s5_unit(UU + (size_t)(b * 64 + g) * SEQ * 16, S5W + (size_t)(l * 64 + g) * 128 * 256, S5TQ + (size_t)(l * 64 + g) * 256 * 384, S5C + (size_t)(l * 64 + g) * 256, args.in[I_S5D] + l * BW + g * 16, Z + (size_t)b * SEQ * BW + g * 16, lds, tid); } }
        }
        SEAM(P + 3);
        RPT(4) if (IN(P + 4)) {
            PTRS();
            { pg8::Gemm g{Z, WgluT, M, BW, BW}; pg8::StaticOrder S; S.init(M, BW, G, bid, 2);
              pg8::EpiGlu E{YCAT, 3 * BW, Z, BW, args.in[I_BGLU] + (size_t)l * BW};
              pg8::gemm_phase<pg8::EpiGlu, pg8::StaticOrder, true, true>(lds, g, S, E); }
            FRESH_IDS();
            post_rows(args, l, H, YCAT, gw, NGW, lane);
        }
        SEAM(P + 4);
        RPT(5) if (IN(P + 5)) {
            PTRS();
            pg8::Gemm g{YCAT, WupT, M, D, 3 * BW}; pg8::StaticOrder S; S.init(M, D, G, bid, 2);
            pg8::EpiMergeK E{MERGED, D, H + HC_MG, NH, D};
            pg8::gemm_phase<pg8::EpiMergeK, pg8::StaticOrder, true, true>(lds, g, S, E);
        }
        SEAM(P + 5);
        RPT(6) if (IN(P + 6)) {
            PTRS();
            pg8::Gemm g{MERGED, WoutT, M, D, D}; pg8::StaticOrder S; S.init(M, D, G, bid, 2);
            pg8::EpiRes E{Y, Y2, l == 0 ? ST0 : ST2, ST0 + 2 * M + (l == 0 ? 0 : 2 * D + (l - 1) * 4 * D + 2 * D)};
            pg8::gemm_phase<pg8::EpiRes, pg8::StaticOrder, true, true>(lds, g, S, E);
        }
        SEAM(P + 6);
        RPT(7) if (IN(P + 7)) { PTRS(); FRESH_IDS(); ln_phase(Y, args.in[I_LN1G] + (size_t)l * D, args.in[I_LN1B] + (size_t)l * D, nullptr, XB, ST1, gw, NGW, lane); }
        SEAM(P + 7);
        RPT(8) if (IN(P + 8)) {
            PTRS();
            pg8::Gemm g{XB, W1T, M, FF, D}; pg8::StaticOrder S; S.init(M, FF, G, bid);
            pg8::EpiRelu2 E{HID, FF};
            pg8::gemm_phase<pg8::EpiRelu2, pg8::StaticOrder, true, true>(lds, g, S, E);
        }
        SEAM(P + 8);
        RPT(9) if (IN(P + 9)) {
            PTRS();
            pg8::Gemm g{HID, W2T, M, D, FF}; pg8::StaticOrder S; S.init(M, D, G, bid, 2);
            pg8::EpiRes E{Y2, Y, ST1, ST0 + 2 * M + 2 * D + l * 4 * D};
            pg8::gemm_phase<pg8::EpiRes, pg8::StaticOrder, true, true>(lds, g, S, E);
        }
        SEAM(P + 9);
    }
    if (IN(DEPTH * NPH)) { PTRS(); FRESH_IDS(); ln_phase(Y2, args.in[I_LN2G] + (size_t)(DEPTH - 1) * D, args.in[I_LN2B] + (size_t)(DEPTH - 1) * D, args.out, XB, ST2, gw, NGW, lane); }
#undef IN
#undef SEAM
}

#ifndef N_SPLIT
#define N_SPLIT 1
#endif
extern "C" void kernel_launch(void* const* d_in, const int* in_sizes, int n_in, void* d_out, int out_size, void* d_ws, size_t ws_size, hipStream_t stream) {
    static int grid = 0;
    if (grid == 0) {
        if (n_in != 25 || out_size != M * D || ws_size < WS_END) { fprintf(stderr, "kernel_launch: unexpected shapes (n_in %d out %d ws %zu need %zu)\n", n_in, out_size, ws_size, (size_t)WS_END); grid = -1; return; }
        int dev = 0, cus = 0;
        if (hipGetDevice(&dev) != hipSuccess || hipDeviceGetAttribute(&cus, hipDeviceAttributeMultiprocessorCount, dev) != hipSuccess) { grid = -1; return; }
        if (hipFuncSetAttribute((const void*)mega_fwd, hipFuncAttributeMaxDynamicSharedMemorySize, LDS_BYTES) != hipSuccess) { fprintf(stderr, "kernel_launch: hipFuncSetAttribute failed\n"); grid = -1; return; }
        int per_cu = 0;
        (void)hipOccupancyMaxActiveBlocksPerMultiprocessor(&per_cu, (const void*)mega_fwd, NWAVES * 64, LDS_BYTES);
        (void)hipGetLastError();
        grid = cus;
    }
    if (grid < 0) return;
    (void)hipMemsetAsync((char*)d_ws + WS_CTL, 0, CTL_ZERO_BYTES, stream);
    Args a{};
    for (int i = 0; i < 25; ++i) a.in[i] = (const float*)d_in[i];
    a.out = (float*)d_out; a.ws = (unsigned char*)d_ws;
#if N_SPLIT == 1
    a.ph_lo = 0; a.ph_hi = DEPTH * NPH + 1; a.bar_idx = 0;
    hipLaunchKernelGGL(mega_fwd, dim3(grid), dim3(NWAVES * 64), LDS_BYTES, stream, a);
#else
    for (int p = 0; p < DEPTH * NPH + 1; ++p) { a.ph_lo = p; a.ph_hi = p + 1; a.bar_idx = 0; hipLaunchKernelGGL(mega_fwd, dim3(grid), dim3(NWAVES * 64), LDS_BYTES, stream, a);
    }
#endif
}
```

```cpp
#include <hip/hip_runtime.h>
#include <cstdio>
#include <cstdint>
namespace pg8 {
#define PG8_LAS __attribute__((address_space(3)))
typedef unsigned short bf16_t;
typedef short bf16x8 __attribute__((ext_vector_type(8)));
typedef float f32x4 __attribute__((ext_vector_type(4)));
typedef unsigned u32x4 __attribute__((ext_vector_type(4)));
constexpr int BM = 256, BK = 64, HALF = 128, HTB = HALF * BK * 2  , STAGE_BYTES = 8 * HTB, NXCD = 8, WGM = 8;

__host__ __device__ __forceinline__ int lds_byte(int r, int c) { const int st = (r >> 4) * 2 + (c >> 5), rr = r & 15, cc = c & 31, ob = rr * 64 + cc * 2; return st * 1024 + (ob ^ (((ob >> 9) & 1) << 5)); }
__host__ __device__ __forceinline__ void stage_rc(int b, int& R, int& C) { const int st = b / 1024, sb = b % 1024, swz = sb ^ (((sb >> 9) & 1) << 5); R = (st >> 1) * 16 + swz / 64; C = (st & 1) * 32 + (swz % 64) / 2; }
__host__ __device__ __forceinline__ int perm32(int rho) { const int n = rho >> 4, i = rho & 15; return 8 * (i >> 2) + 4 * n + (i & 3); }

struct Unit { int pm, pn; };
struct Gemm { const bf16_t* A; const bf16_t* Bt; int M, N, K; };

struct StaticOrder {
    int nM, nN, nwg, G, c, wgm;
    __host__ __device__ void init(int M, int N, int G_, int c_, int wgm_ = WGM) { nM = M / BM; nN = N / BM; nwg = nM * nN; G = G_; c = c_; wgm = wgm_; }
    __host__ __device__ bool next(int i, Unit& u) const {
        const long L = (long)i * G + c; if (L >= nwg) return false;
        int wgid = (int)L; { const int q = nwg / NXCD, r = nwg % NXCD, xcd = wgid % NXCD, off = wgid / NXCD; wgid = (xcd < r ? xcd * (q + 1) : r * (q + 1) + (xcd - r) * q) + off; }
        const int nig = wgm * nN, gid = wgid / nig, fm = gid * wgm, gsz = (nM - fm) < wgm ? (nM - fm) : wgm;
        u.pm = fm + ((wgid % nig) % gsz); u.pn = (wgid % nig) / gsz; return true;
    }
    __device__ __forceinline__ void a_ready(const Unit&) const {}
    __device__ __forceinline__ void done(const Unit&) const {}
};

__device__ __forceinline__ unsigned cvt_pk_bf16(float lo, float hi) { unsigned r; asm volatile("v_cvt_pk_bf16_f32 %0, %1, %2" : "=v"(r) : "v"(lo), "v"(hi)); return r; }
typedef float f32x2 __attribute__((ext_vector_type(2)));

typedef unsigned u32x2 __attribute__((ext_vector_type(2)));
__device__ __forceinline__ float bf_lo(unsigned w) { return __uint_as_float(w << 16); }
__device__ __forceinline__ float bf_hi(unsigned w) { return __uint_as_float(w & 0xffff0000u); }
__device__ __forceinline__ float sigmoidf_(float x) { return __builtin_amdgcn_rcpf(1.0f + __expf(-x)); }

typedef _Float16 f16x2_ __attribute__((ext_vector_type(2)));
__device__ __forceinline__ unsigned cvt_pk_f16(float lo, float hi) { const f32x2 v = {lo, hi}; const f16x2_ h = __builtin_convertvector(v, f16x2_); return __builtin_bit_cast(unsigned, h); }
__device__ __forceinline__ f32x2 unpk_f16(unsigned w) { const f16x2_ h = __builtin_bit_cast(f16x2_, w); return __builtin_convertvector(h, f32x2); }
struct EpiBf16Plain {
    static constexpr bool PERM = true, AFTER_DRAIN = false;
    bf16_t* O; int ldc;
    __device__ __forceinline__ void operator()(const f32x4 (&acc)[2][2][4][2], const Unit& u, int wr, int wc, int fr, int fq) const {
        const int row0 = u.pm * BM + wr * 64 + fr, col0 = u.pn * BM + wc * 32 + 8 * fq;
#pragma unroll
        for (int ai = 0; ai < 2; ++ai)
#pragma unroll
            for (int m = 0; m < 4; ++m) { bf16_t* rowp = O + (size_t)(row0 + ai * HALF + m * 16) * ldc + col0;
#pragma unroll
                for (int bj = 0; bj < 2; ++bj) { const f32x4 v0 = acc[ai][bj][m][0], v1 = acc[ai][bj][m][1];
                    u32x4 w; w.x = cvt_pk_bf16(v0[0], v0[1]); w.y = cvt_pk_bf16(v0[2], v0[3]); w.z = cvt_pk_bf16(v1[0], v1[1]); w.w = cvt_pk_bf16(v1[2], v1[3]);
                    *(u32x4*)(rowp + bj * HALF) = w; } }
    }
};
struct EpiH {
    static constexpr bool PERM = true, AFTER_DRAIN = false;
    bf16_t* O; int ldc; bf16_t* U;
    __device__ __forceinline__ void operator()(const f32x4 (&acc)[2][2][4][2], const Unit& u, int wr, int wc, int fr, int fq) const {
        const int row0 = u.pm * BM + wr * 64 + fr, col0 = u.pn * BM + wc * 32 + 8 * fq;
        const bool isu = u.pn < 4, isg = u.pn >= 32;
#pragma unroll
        for (int ai = 0; ai < 2; ++ai)
#pragma unroll
            for (int m = 0; m < 4; ++m) { const int row = row0 + ai * HALF + m * 16;
#pragma unroll
                for (int bj = 0; bj < 2; ++bj) { f32x4 v0 = acc[ai][bj][m][0], v1 = acc[ai][bj][m][1];
                    if (isg) {
#pragma unroll
                        for (int j = 0; j < 4; ++j) { v0[j] = __builtin_amdgcn_rcpf(1.0f + __expf(-fminf(fmaxf(v0[j], -30.f), 30.f))); v1[j] = __builtin_amdgcn_rcpf(1.0f + __expf(-fminf(fmaxf(v1[j], -30.f), 30.f))); } }
                    u32x4 w; w.x = cvt_pk_bf16(v0[0], v0[1]); w.y = cvt_pk_bf16(v0[2], v0[3]); w.z = cvt_pk_bf16(v1[0], v1[1]); w.w = cvt_pk_bf16(v1[2], v1[3]);
                    const int col = col0 + bj * HALF;
                    bf16_t* dst = isu ? U + ((size_t)((row >> 12) * 64 + (col >> 4)) * 4096 + (row & 4095)) * 16 + (col & 8) : O + (size_t)row * ldc + col;
                    *(u32x4*)dst = w; } }
    }
};
struct EpiRelu2 {
    static constexpr bool PERM = true, AFTER_DRAIN = false;
    bf16_t* O; int ldc;
    __device__ __forceinline__ void operator()(const f32x4 (&acc)[2][2][4][2], const Unit& u, int wr, int wc, int fr, int fq) const {
        const int row0 = u.pm * BM + wr * 64 + fr, col0 = u.pn * BM + wc * 32 + 8 * fq;
#pragma unroll
        for (int ai = 0; ai < 2; ++ai)
#pragma unroll
            for (int m = 0; m < 4; ++m) { bf16_t* rowp = O + (size_t)(row0 + ai * HALF + m * 16) * ldc + col0;
#pragma unroll
                for (int bj = 0; bj < 2; ++bj) { f32x4 v0 = acc[ai][bj][m][0], v1 = acc[ai][bj][m][1];
#pragma unroll
                    for (int j = 0; j < 4; ++j) { const float a = fmaxf(v0[j], 0.f), b = fmaxf(v1[j], 0.f); v0[j] = a * a; v1[j] = b * b; }
                    u32x4 w; w.x = cvt_pk_bf16(v0[0], v0[1]); w.y = cvt_pk_bf16(v0[2], v0[3]); w.z = cvt_pk_bf16(v1[0], v1[1]); w.w = cvt_pk_bf16(v1[2], v1[3]);
                    *(u32x4*)(rowp + bj * HALF) = w; } }
    }
};
struct EpiGlu {
    static constexpr bool PERM = true, AFTER_DRAIN = false;
    bf16_t* O; int ldc; const bf16_t* Z; int ldz; const float* bias;
    __device__ __forceinline__ void operator()(const f32x4 (&acc)[2][2][4][2], const Unit& u, int wr, int wc, int fr, int fq) const {
        const int row0 = u.pm * BM + wr * 64 + fr, col0 = u.pn * BM + wc * 32 + 8 * fq;
        f32x4 bv[2][2];
#pragma unroll
        for (int bj = 0; bj < 2; ++bj)
#pragma unroll
            for (int n = 0; n < 2; ++n) bv[bj][n] = *(const f32x4*)(bias + col0 + bj * HALF + 4 * n);
#pragma unroll
        for (int ai = 0; ai < 2; ++ai)
#pragma unroll
            for (int m = 0; m < 4; ++m) { const size_t r = (size_t)(row0 + ai * HALF + m * 16);
#pragma unroll
                for (int bj = 0; bj < 2; ++bj) { f32x4 v0 = acc[ai][bj][m][0] + bv[bj][0], v1 = acc[ai][bj][m][1] + bv[bj][1];
                    const u32x4 zz = *(const u32x4*)(Z + r * ldz + col0 + bj * HALF);
                    v0[0] = bf_lo(zz.x) * sigmoidf_(v0[0]); v0[1] = bf_hi(zz.x) * sigmoidf_(v0[1]); v0[2] = bf_lo(zz.y) * sigmoidf_(v0[2]); v0[3] = bf_hi(zz.y) * sigmoidf_(v0[3]);
                    v1[0] = bf_lo(zz.z) * sigmoidf_(v1[0]); v1[1] = bf_hi(zz.z) * sigmoidf_(v1[1]); v1[2] = bf_lo(zz.w) * sigmoidf_(v1[2]); v1[3] = bf_hi(zz.w) * sigmoidf_(v1[3]);
                    u32x4 w; w.x = cvt_pk_bf16(v0[0], v0[1]); w.y = cvt_pk_bf16(v0[2], v0[3]); w.z = cvt_pk_bf16(v1[0], v1[1]); w.w = cvt_pk_bf16(v1[2], v1[3]);
                    *(u32x4*)(O + r * ldc + col0 + bj * HALF) = w; } }
    }
};
struct EpiRes {
    static constexpr bool PERM = true, AFTER_DRAIN = false, HAS_INIT = true;
    static constexpr int ldc = 2048; static constexpr float alpha = 1.681792830507429f;
    bf16_t* Y; const bf16_t* X;
    const float* ST; const float* GB;
    __device__ __forceinline__ void init(f32x4 (&acc)[2][2][4][2], const Unit& u, int wr, int wc, int fr_, int fq) const {
        int fr = fr_; asm volatile("" : "+v"(fr));
        const int row0 = u.pm * BM + wr * 64 + fr, col0 = u.pn * BM + wc * 32 + 8 * fq;
#pragma unroll
        for (int ai = 0; ai < 2; ++ai)
#pragma unroll
            for (int m = 0; m < 4; ++m) { const bf16_t* rp = X + (size_t)(row0 + ai * HALF + m * 16) * ldc + col0;
#pragma unroll
                for (int bj = 0; bj < 2; ++bj) { const u32x4 w = *(const u32x4*)(rp + bj * HALF);
                    const f32x2 a = unpk_f16(w.x), b = unpk_f16(w.y), c = unpk_f16(w.z), d = unpk_f16(w.w);
                    acc[ai][bj][m][0] = (f32x4){a.x, a.y, b.x, b.y}; acc[ai][bj][m][1] = (f32x4){c.x, c.y, d.x, d.y}; } }
        f32x2 st[2][4];
#pragma unroll
        for (int ai = 0; ai < 2; ++ai)
#pragma unroll
            for (int m = 0; m < 4; ++m) st[ai][m] = *(const f32x2*)(ST + 2 * (size_t)(row0 + ai * HALF + m * 16));
#pragma unroll
        for (int bj = 0; bj < 2; ++bj)
#pragma unroll
            for (int n = 0; n < 2; ++n) { const int c = col0 + bj * HALF + n * 4;
                const f32x4 gv = *(const f32x4*)(GB + c) * alpha, bv = *(const f32x4*)(GB + ldc + c) * alpha;
#pragma unroll
                for (int ai = 0; ai < 2; ++ai)
#pragma unroll
                    for (int m = 0; m < 4; ++m) acc[ai][bj][m][n] = (acc[ai][bj][m][n] - st[ai][m].x) * st[ai][m].y * gv + bv; }
    }
    __device__ __forceinline__ void operator()(const f32x4 (&acc)[2][2][4][2], const Unit& u, int wr, int wc, int fr, int fq) const {
        const int row0 = u.pm * BM + wr * 64 + fr, col0 = u.pn * BM + wc * 32 + 8 * fq;
#pragma unroll
        for (int ai = 0; ai < 2; ++ai)
#pragma unroll
            for (int m = 0; m < 4; ++m) { bf16_t* rowp = Y + (size_t)(row0 + ai * HALF + m * 16) * ldc + col0;
#pragma unroll
                for (int bj = 0; bj < 2; ++bj) { const f32x4 v0 = acc[ai][bj][m][0], v1 = acc[ai][bj][m][1];
                    u32x4 w; w.x = cvt_pk_f16(v0[0], v0[1]); w.y = cvt_pk_f16(v0[2], v0[3]); w.z = cvt_pk_f16(v1[0], v1[1]); w.w = cvt_pk_f16(v1[2], v1[3]);
                    *(u32x4*)(rowp + bj * HALF) = w; } }
    }
};
template <int MODE> struct EpiMerge {
    static constexpr bool PERM = false, AFTER_DRAIN = false;
    float* T; bf16_t* O; int ldc; const bf16_t* G; int ldg;
    __device__ __forceinline__ void operator()(const f32x4 (&acc)[2][2][4][2], const Unit& u, int wr, int wc, int fr, int fq) const {
        const int row0 = u.pm * BM + wr * 64 + fr, col0 = u.pn * BM + wc * 32 + 4 * fq;
#pragma unroll
        for (int ai = 0; ai < 2; ++ai)
#pragma unroll
            for (int m = 0; m < 4; ++m) { const size_t r = (size_t)(row0 + ai * HALF + m * 16);
#pragma unroll
                for (int bj = 0; bj < 2; ++bj)
#pragma unroll
                    for (int n = 0; n < 2; ++n) { const int c = col0 + bj * HALF + n * 16;
                        const u32x2 gg = *(const u32x2*)(G + r * ldg + c);
                        f32x4 gv; gv[0] = sigmoidf_(bf_lo(gg.x)); gv[1] = sigmoidf_(bf_hi(gg.x)); gv[2] = sigmoidf_(bf_lo(gg.y)); gv[3] = sigmoidf_(bf_hi(gg.y));
                        f32x4 v = gv * acc[ai][bj][m][n];
                        if (MODE != 0) v = v + *(const f32x4*)(T + r * ldc + c);
                        if (MODE != 2) *(f32x4*)(T + r * ldc + c) = v;
                        else { u32x2 w; w.x = cvt_pk_bf16(v[0], v[1]); w.y = cvt_pk_bf16(v[2], v[3]); *(u32x2*)(O + r * ldc + c) = w; } } }
    }
};

struct EpiMergeK {
    static constexpr bool PERM = true, AFTER_DRAIN = false, HAS_HOOK = true;
    bf16_t* O; int ldc; const bf16_t* G; int ldg; int gstride;
    __device__ __forceinline__ void hook(f32x4 (&acc)[2][2][4][2], const Unit& u, int seam, int wr, int wc, int fr_, int fq) const {
        int fr = fr_; asm volatile("" : "+v"(fr));
        const int row0 = u.pm * BM + wr * 64 + fr, col0 = u.pn * BM + wc * 32 + 8 * fq;
        const bf16_t* gn = G + (size_t)(seam - 1) * gstride; const bf16_t* gd = gn + gstride;
#pragma unroll
        for (int ai = 0; ai < 2; ++ai) {
            u32x4 a[4][2], b[4][2];
#pragma unroll
            for (int m = 0; m < 4; ++m) { const size_t r = (size_t)(row0 + ai * HALF + m * 16) * ldg + col0;
#pragma unroll
                for (int bj = 0; bj < 2; ++bj) { a[m][bj] = *(const u32x4*)(gn + r + bj * HALF); b[m][bj] = *(const u32x4*)(gd + r + bj * HALF); } }
#pragma unroll
            for (int m = 0; m < 4; ++m)
#pragma unroll
                for (int bj = 0; bj < 2; ++bj) { const u32x4 x = a[m][bj], y = b[m][bj];
                    f32x4 q0, q1;
                    q0[0] = bf_lo(x.x) * __builtin_amdgcn_rcpf(bf_lo(y.x)); q0[1] = bf_hi(x.x) * __builtin_amdgcn_rcpf(bf_hi(y.x)); q0[2] = bf_lo(x.y) * __builtin_amdgcn_rcpf(bf_lo(y.y)); q0[3] = bf_hi(x.y) * __builtin_amdgcn_rcpf(bf_hi(y.y));
                    q1[0] = bf_lo(x.z) * __builtin_amdgcn_rcpf(bf_lo(y.z)); q1[1] = bf_hi(x.z) * __builtin_amdgcn_rcpf(bf_hi(y.z)); q1[2] = bf_lo(x.w) * __builtin_amdgcn_rcpf(bf_lo(y.w)); q1[3] = bf_hi(x.w) * __builtin_amdgcn_rcpf(bf_hi(y.w));
                    acc[ai][bj][m][0] = acc[ai][bj][m][0] * q0; acc[ai][bj][m][1] = acc[ai][bj][m][1] * q1; }
            asm volatile("" ::: "memory"); }
    }
    __device__ __forceinline__ void operator()(const f32x4 (&acc)[2][2][4][2], const Unit& u, int wr, int wc, int fr, int fq) const {
        const int row0 = u.pm * BM + wr * 64 + fr, col0 = u.pn * BM + wc * 32 + 8 * fq;
        const bf16_t* g2 = G + (size_t)2 * gstride;
#pragma unroll
        for (int ai = 0; ai < 2; ++ai)
#pragma unroll
            for (int m = 0; m < 4; ++m) { const size_t r = (size_t)(row0 + ai * HALF + m * 16);
#pragma unroll
                for (int bj = 0; bj < 2; ++bj) { const u32x4 a = *(const u32x4*)(g2 + r * ldg + col0 + bj * HALF);
                    const f32x4 v0 = acc[ai][bj][m][0], v1 = acc[ai][bj][m][1];
                    u32x4 w; w.x = cvt_pk_bf16(v0[0] * bf_lo(a.x), v0[1] * bf_hi(a.x)); w.y = cvt_pk_bf16(v0[2] * bf_lo(a.y), v0[3] * bf_hi(a.y));
                    w.z = cvt_pk_bf16(v1[0] * bf_lo(a.z), v1[1] * bf_hi(a.z)); w.w = cvt_pk_bf16(v1[2] * bf_lo(a.w), v1[3] * bf_hi(a.w));
                    *(u32x4*)(O + r * ldc + col0 + bj * HALF) = w; } }
    }
};
template <class E, class = void> struct epi_has_init { static constexpr bool value = false; };
template <class E> struct epi_has_init<E, decltype((void)E::HAS_INIT)> { static constexpr bool value = E::HAS_INIT; };
template <class E, class = void> struct epi_has_hook { static constexpr bool value = false; };
template <class E> struct epi_has_hook<E, decltype((void)E::HAS_HOOK)> { static constexpr bool value = E::HAS_HOOK; };

template <class Epi, class Sched, bool ALIGN_EPI = false, bool SP2 = false>
__device__ __forceinline__ void gemm_phase_ld(PG8_LAS unsigned char* lds, const Gemm g, const int lda, const int ldb, const Sched& S, const Epi& E) {
    int tid_ = threadIdx.x; asm volatile("" : "+v"(tid_));
    const int tid = tid_, wid = __builtin_amdgcn_readfirstlane(tid >> 6), lane = tid & 63, wr = wid >> 2, wc = wid & 3, fr = lane & 15, fq = lane >> 4;
    const int K = g.K, nt = K / BK;
    unsigned voffA[2], voffB[2];
#pragma unroll
    for (int i = 0; i < 2; ++i) { int R, C; stage_rc(tid * 16 + i * 8192, R, C); const int Rb = Epi::PERM ? ((R & ~31) + perm32(R & 31)) : R;
        voffA[i] = (unsigned)(R * lda + C) * 2u; voffB[i] = (unsigned)(Rb * ldb + C) * 2u; }
    const size_t kstep = (size_t)(BK * 2);
    const size_t hstepA = (size_t)HALF * lda * 2, hstepB = (size_t)HALF * ldb * 2;
    const size_t tstepA = 2 * hstepA, tstepB = 2 * hstepB;
    const unsigned ldsw = (unsigned)wid * 1024u;
    const int aoff = lds_byte(wr * 64 + fr, fq * 8), boff = lds_byte(wc * 32 + fr, fq * 8);
#define PG8_SA(b, h) (((b) * 2 + (h)) * HTB)
#define PG8_SB(b, h) ((4 + (b) * 2 + (h)) * HTB)
#define PG8_STAGE(bufoff, gbase, voff) do { _Pragma("unroll") for (int _i = 0; _i < 2; ++_i) \
        __builtin_amdgcn_global_load_lds((const unsigned*)((const char*)(gbase) + (voff)[_i]), (PG8_LAS unsigned*)(lds + (bufoff) + ldsw + _i * 8192), 16, 0, 0); } while (0)
#define PG8_LDA(dst, b, h) do { _Pragma("unroll") for (int m = 0; m < 4; ++m) _Pragma("unroll") for (int k = 0; k < 2; ++k) dst[m][k] = *(const PG8_LAS bf16x8*)(lds + PG8_SA(b, h) + aoff + m * 2048 + k * 1024); } while (0)
#define PG8_LDB(dst, b, h) do { _Pragma("unroll") for (int n = 0; n < 2; ++n) _Pragma("unroll") for (int k = 0; k < 2; ++k) dst[n][k] = *(const PG8_LAS bf16x8*)(lds + PG8_SB(b, h) + boff + n * 2048 + k * 1024); } while (0)
#define PG8_MMA(ai, bj, At, Bt) do { __builtin_amdgcn_s_setprio(1); _Pragma("unroll") for (int m = 0; m < 4; ++m) _Pragma("unroll") for (int n = 0; n < 2; ++n) _Pragma("unroll") for (int k = 0; k < 2; ++k) \
        acc[ai][bj][m][n] = __builtin_amdgcn_mfma_f32_16x16x32_bf16(Bt[n][k], At[m][k], acc[ai][bj][m][n], 0, 0, 0); __builtin_amdgcn_s_setprio(0); } while (0)
#define PG8_WAIT_V(n) asm volatile("s_waitcnt vmcnt(" #n ")" ::: "memory")
#define PG8_WAIT_L(n) asm volatile("s_waitcnt lgkmcnt(" #n ")" ::: "memory")
#define PG8_BAR __builtin_amdgcn_s_barrier()
#define PG8_SCHED __builtin_amdgcn_sched_barrier(0)
    Unit cur, nxt; int ui = 0;
    if (!S.next(0, cur)) return;
    f32x4 acc[2][2][4][2];
    if constexpr (epi_has_init<Epi>::value) E.init(acc, cur, wr, wc, fr, fq);
    else {
#pragma unroll
    for (int a = 0; a < 2; ++a)
#pragma unroll
        for (int b = 0; b < 2; ++b)
#pragma unroll
            for (int m = 0; m < 4; ++m)
#pragma unroll
                for (int n = 0; n < 2; ++n) acc[a][b][m][n] = (f32x4){0.f, 0.f, 0.f, 0.f};
    }
    bf16x8 At[4][2], B0[2][2], B1[2][2];
    const char* cA = (const char*)g.A + (size_t)cur.pm * tstepA; const char* cB = (const char*)g.Bt + (size_t)cur.pn * tstepB;
    S.a_ready(cur);
    if constexpr (SP2) {
        PG8_STAGE(PG8_SB(0, 0), cB, voffB); PG8_STAGE(PG8_SB(0, 1), cB + hstepB, voffB); PG8_STAGE(PG8_SA(0, 0), cA, voffA); PG8_STAGE(PG8_SA(0, 1), cA + hstepA, voffA);
        if (wr == 1) PG8_BAR;
        PG8_WAIT_V(2); PG8_BAR;
        PG8_STAGE(PG8_SB(1, 0), cB + kstep, voffB); PG8_STAGE(PG8_SA(1, 0), cA + kstep, voffA); PG8_STAGE(PG8_SB(1, 1), cB + hstepB + kstep, voffB);
        PG8_WAIT_V(6); PG8_BAR;
    } else {
        PG8_STAGE(PG8_SB(0, 0), cB, voffB); PG8_STAGE(PG8_SA(0, 0), cA, voffA); PG8_STAGE(PG8_SB(0, 1), cB + hstepB, voffB); PG8_STAGE(PG8_SA(0, 1), cA + hstepA, voffA);
        if (wr == 1) PG8_BAR;
        PG8_WAIT_V(4); PG8_BAR;
        PG8_STAGE(PG8_SB(1, 0), cB + kstep, voffB); PG8_STAGE(PG8_SA(1, 0), cA + kstep, voffA); PG8_STAGE(PG8_SB(1, 1), cB + hstepB + kstep, voffB);
        PG8_WAIT_V(6); PG8_BAR;
    }
    for (;;) {
        const bool has_next = S.next(ui + 1, nxt);
        const char* nA = has_next ? (const char*)g.A + (size_t)nxt.pm * tstepA : cA; const char* nB = has_next ? (const char*)g.Bt + (size_t)nxt.pn * tstepB : cB;
        for (int t = 0; t < nt; t += 2) {
            const bool last = (t == nt - 2);
            const char* a1 = cA + (size_t)(t + 1) * kstep;
            const char* a2 = last ? nA : cA + (size_t)(t + 2) * kstep; const char* b2 = last ? nB : cB + (size_t)(t + 2) * kstep;
            const char* a3 = a2 + kstep; const char* b3 = b2 + kstep;
            if (last && has_next) S.a_ready(nxt);
            if constexpr (epi_has_hook<Epi>::value) { if (t == 16 || t == 32) { f32x4 (&acc_)[2][2][4][2] = acc; E.hook(acc_, cur, t >> 4, wr, wc, fr, fq); } }
            if constexpr (SP2) {
            PG8_LDB(B0, 0, 0); PG8_LDB(B1, 0, 1); PG8_SCHED; PG8_LDA(At, 0, 0); PG8_STAGE(PG8_SA(1, 1), a1 + hstepA, voffA);
            PG8_WAIT_V(8); PG8_WAIT_L(0); PG8_BAR; PG8_MMA(0, 0, At, B0); PG8_MMA(0, 1, At, B1); PG8_BAR; PG8_SCHED;
            PG8_LDA(At, 0, 1); PG8_STAGE(PG8_SB(0, 0), b2, voffB); PG8_STAGE(PG8_SB(0, 1), b2 + hstepB, voffB); PG8_STAGE(PG8_SA(0, 0), a2, voffA);
            PG8_WAIT_V(8); PG8_WAIT_L(0); PG8_BAR; PG8_MMA(1, 0, At, B0); PG8_MMA(1, 1, At, B1); PG8_BAR; PG8_SCHED;
            PG8_LDB(B0, 1, 0); PG8_LDB(B1, 1, 1); PG8_SCHED; PG8_LDA(At, 1, 0); PG8_STAGE(PG8_SA(0, 1), a2 + hstepA, voffA);
            PG8_WAIT_V(8); PG8_WAIT_L(0); PG8_BAR; PG8_MMA(0, 0, At, B0); PG8_MMA(0, 1, At, B1); PG8_BAR; PG8_SCHED;
            PG8_LDA(At, 1, 1); PG8_STAGE(PG8_SB(1, 0), b3, voffB); PG8_STAGE(PG8_SB(1, 1), b3 + hstepB, voffB); PG8_STAGE(PG8_SA(1, 0), a3, voffA);
            PG8_WAIT_V(8); PG8_WAIT_L(0); PG8_BAR; PG8_MMA(1, 0, At, B0); PG8_MMA(1, 1, At, B1); PG8_BAR; PG8_SCHED;
            } else {
            PG8_LDB(B0, 0, 0); PG8_SCHED; PG8_LDA(At, 0, 0); PG8_STAGE(PG8_SA(1, 1), a1 + hstepA, voffA);
            PG8_WAIT_L(8); PG8_BAR; PG8_WAIT_L(0); PG8_MMA(0, 0, At, B0); PG8_BAR; PG8_SCHED;
            PG8_LDB(B1, 0, 1); PG8_STAGE(PG8_SB(0, 0), b2, voffB);
            PG8_BAR; PG8_WAIT_L(0); PG8_MMA(0, 1, At, B1); PG8_BAR;
            PG8_LDA(At, 0, 1); PG8_STAGE(PG8_SA(0, 0), a2, voffA);
            PG8_BAR; PG8_WAIT_L(0); PG8_MMA(1, 0, At, B0); PG8_BAR; PG8_SCHED;
            PG8_STAGE(PG8_SB(0, 1), b2 + hstepB, voffB);
            PG8_WAIT_V(6); PG8_BAR; PG8_MMA(1, 1, At, B1); PG8_BAR;
            PG8_LDB(B0, 1, 0); PG8_SCHED; PG8_LDA(At, 1, 0); PG8_STAGE(PG8_SA(0, 1), a2 + hstepA, voffA);
            PG8_WAIT_L(8); PG8_BAR; PG8_WAIT_L(0); PG8_MMA(0, 0, At, B0); PG8_BAR; PG8_SCHED;
            PG8_LDB(B1, 1, 1); PG8_STAGE(PG8_SB(1, 0), b3, voffB);
            PG8_BAR; PG8_WAIT_L(0); PG8_MMA(0, 1, At, B1); PG8_BAR;
            PG8_LDA(At, 1, 1); PG8_STAGE(PG8_SA(1, 0), a3, voffA);
            PG8_BAR; PG8_WAIT_L(0); PG8_MMA(1, 0, At, B0); PG8_BAR; PG8_SCHED;
            PG8_STAGE(PG8_SB(1, 1), b3 + hstepB, voffB);
            PG8_WAIT_V(6); PG8_BAR; PG8_MMA(1, 1, At, B1); PG8_BAR;
            }
        }
        if constexpr (ALIGN_EPI) { if (wr == 0) PG8_BAR; }
        if constexpr (!Epi::AFTER_DRAIN) { E(acc, cur, wr, wc, fr, fq); S.done(cur); }
        if (!has_next) break;
        if constexpr (epi_has_init<Epi>::value) E.init(acc, nxt, wr, wc, fr, fq);
        else {
#pragma unroll
        for (int a = 0; a < 2; ++a)
#pragma unroll
            for (int b = 0; b < 2; ++b)
#pragma unroll
                for (int m = 0; m < 4; ++m)
#pragma unroll
                    for (int n = 0; n < 2; ++n) acc[a][b][m][n] = (f32x4){0.f, 0.f, 0.f, 0.f};
        }
        cur = nxt; cA = nA; cB = nB; ++ui;
        if constexpr (ALIGN_EPI) { if (wr == 1) PG8_BAR; }
    }
    PG8_WAIT_V(0);
    if constexpr (!ALIGN_EPI) { if (wr == 0) PG8_BAR; }
    PG8_BAR;
    if constexpr (Epi::AFTER_DRAIN) { E.fused(acc, cur, wr, wc, fr, fq, lds, wid, lane); S.done(cur); }
#undef PG8_SA
#undef PG8_SB
#undef PG8_STAGE
#undef PG8_LDA
#undef PG8_LDB
#undef PG8_MMA
#undef PG8_WAIT_V
#undef PG8_WAIT_L
#undef PG8_BAR
#undef PG8_SCHED
}
template <class Epi, class Sched, bool ALIGN_EPI = false, bool SP2 = false>
__device__ __forceinline__ void gemm_phase(PG8_LAS unsigned char* lds, const Gemm g, const Sched& S, const Epi& E) { gemm_phase_ld<Epi, Sched, ALIGN_EPI, SP2>(lds, g, g.K, g.K, S, E); }
}

constexpr int NB = 4, SEQ = 4096, M = NB * SEQ, D = 2048, DEPTH = 4, BW = 1024;
constexpr int IN_TOTAL = 14352, NH = 14336;
constexpr int HC_U = 0, HC_GQ = 1024, HC_GK = 1536, HC_GV = 2048, HC_GG = 3072, HC_HQ = 4096, HC_HF = 5120, HC_HI = 6144, HC_HG = 7168, HC_MG = 8192;
constexpr int GLOW_COL = 3072;
constexpr int FF = 8192;
constexpr float DN_ALPHA = 1.681792830507429f;
constexpr float LN_EPS = 1e-5f, RMS_EPS = 1e-6f;
constexpr int NPH = 10;
constexpr int NBLK = SEQ / 16;
constexpr int BND_Q2 = 0, BND_K2T = 8704, BND_GL = 16896, BND_A2 = 17408, BND_BYTES = 20480, BND_ROW = 272;
constexpr int NPAIR = SEQ / 32;
constexpr int SLOT_VT = BND_BYTES, SLOT_BYTES = BND_BYTES + 4096;

constexpr size_t MiB = 1u << 20;
constexpr size_t WS_CTL = 0, CTL_ZERO_BYTES = 1 * MiB;
constexpr size_t WS_WIN = 1 * MiB;
constexpr size_t WS_WGLU = WS_WIN + 56 * MiB;
constexpr size_t WS_WUP = WS_WGLU + 2 * MiB;
constexpr size_t WS_WOUT = WS_WUP + 12 * MiB;
constexpr size_t WS_W1 = WS_WOUT + 8 * MiB;
constexpr size_t WS_W2 = WS_W1 + 32 * MiB;
constexpr size_t WS_XB = WS_W2 + 32 * MiB;
constexpr size_t WS_Y = WS_XB + 64 * MiB;
constexpr size_t WS_BND = WS_XB;
constexpr size_t WS_H = WS_Y + 128 * MiB;
constexpr size_t WS_Z = WS_H + 448 * MiB;
constexpr size_t WS_YCAT = WS_Z + 32 * MiB;
constexpr size_t WS_MERGED = WS_YCAT + 96 * MiB;
constexpr size_t WS_VT = WS_MERGED;
constexpr size_t WS_GLOW = WS_MERGED + 64 * MiB;
constexpr size_t WS_U = WS_GLOW + 1 * MiB;
constexpr size_t WS_S5W = WS_U + 32 * MiB;
constexpr size_t WS_S5TQ = WS_S5W + 16 * MiB;
constexpr size_t WS_S5C = WS_S5TQ + 48 * MiB;
constexpr size_t WS_WGLOW = WS_S5C + 1 * MiB;
constexpr size_t WS_Y2 = WS_WGLOW + 1 * MiB;
constexpr size_t WS_ST = WS_Y2 + 128 * MiB;
constexpr size_t WS_ID = WS_ST + 1 * MiB;
constexpr size_t WS_END = WS_ID + 1 * MiB;
static_assert((size_t)48 * NPAIR * BND_BYTES <= 192 * MiB, "bundles fit XB + Y");
constexpr int CW_BAR = 4096;

constexpr int NWAVES = 8;
constexpr int RING_BYTES = 131072, LDS_BYTES = 163840, LDSCTL_OFF = LDS_BYTES - 1024, MISC_OFF = LDSCTL_OFF + 320;

#define GAS __attribute__((address_space(1)))
#define LAS __attribute__((address_space(3)))
typedef unsigned short bf16;
typedef unsigned v4u __attribute__((ext_vector_type(4)));
typedef unsigned v2u __attribute__((ext_vector_type(2)));
typedef float f32x4 __attribute__((ext_vector_type(4)));
typedef short bf16x8 __attribute__((ext_vector_type(8)));
#define LDS_WAIT() asm volatile("s_waitcnt lgkmcnt(0)" ::: "memory")
__device__ __forceinline__ unsigned f2bf(float f) { unsigned u = __builtin_bit_cast(unsigned, f); return (u + 0x7fffu + ((u >> 16) & 1u)) >> 16; }
__device__ __forceinline__ unsigned pk2(float lo, float hi) { return f2bf(lo) | (f2bf(hi) << 16); }
typedef __bf16 bfx2_t __attribute__((ext_vector_type(2)));
typedef float f32x2_t __attribute__((ext_vector_type(2)));
__device__ __forceinline__ unsigned cvtpk(float lo, float hi) { const f32x2_t v = {lo, hi}; const bfx2_t b = __builtin_convertvector(v, bfx2_t); return __builtin_bit_cast(unsigned, b); }
typedef _Float16 f16x2_t __attribute__((ext_vector_type(2)));
__device__ __forceinline__ unsigned cvtpk_h(float lo, float hi) { const f32x2_t v = {lo, hi}; const f16x2_t h = __builtin_convertvector(v, f16x2_t); return __builtin_bit_cast(unsigned, h); }
__device__ __forceinline__ f32x2_t unpk_h(unsigned w) { const f16x2_t h = __builtin_bit_cast(f16x2_t, w); return __builtin_convertvector(h, f32x2_t); }
__device__ __forceinline__ float bf2f(bf16 v) { return __uint_as_float(((unsigned)v) << 16); }
__device__ __forceinline__ float bflo(unsigned w) { return __uint_as_float(w << 16); }
__device__ __forceinline__ float bfhi(unsigned w) { return __uint_as_float(w & 0xffff0000u); }
#define DPP_ADD(v, ctrl) ((v) + __builtin_bit_cast(float, __builtin_amdgcn_update_dpp(0, __builtin_bit_cast(int, (v)), (ctrl), 0xF, 0xF, false)))
__device__ __forceinline__ float row16_sum(float v) {
    v = DPP_ADD(v, 0xB1); v = DPP_ADD(v, 0x4E); v = DPP_ADD(v, 0x141); v = DPP_ADD(v, 0x140);
    return v;
}
__device__ __forceinline__ float wave_sum(float v) {
    v = row16_sum(v);
    const int vi = __builtin_bit_cast(int, v);
    return (__builtin_bit_cast(float, __builtin_amdgcn_readlane(vi, 0)) + __builtin_bit_cast(float, __builtin_amdgcn_readlane(vi, 16))) + (__builtin_bit_cast(float, __builtin_amdgcn_readlane(vi, 32)) + __builtin_bit_cast(float, __builtin_amdgcn_readlane(vi, 48)));
}
__device__ __forceinline__ float half_sum(float v, int lane) {
    const int vi = __builtin_bit_cast(int, row16_sum(v));
    const float lo = __builtin_bit_cast(float, __builtin_amdgcn_readlane(vi, 0)) + __builtin_bit_cast(float, __builtin_amdgcn_readlane(vi, 16)), hi = __builtin_bit_cast(float, __builtin_amdgcn_readlane(vi, 32)) + __builtin_bit_cast(float, __builtin_amdgcn_readlane(vi, 48));
    return (lane & 32) ? hi : lo;
}
__device__ __forceinline__ float sigm(float x) { return __builtin_amdgcn_rcpf(1.0f + __expf(-x)); }
__device__ __forceinline__ float gelu_tanh(float x) { const float u = 0.7978845608028654f * (x + 0.044715f * x * x * x); return 0.5f * x * (1.0f + tanhf(u)); }
__device__ __forceinline__ float logsigmoidf_(float z) { return fminf(z, 0.f) - log1pf(expf(-fabsf(z))); }
__device__ __forceinline__ bf16x8 mk8(unsigned a, unsigned b, unsigned c, unsigned d) { v4u t; t.x = a; t.y = b; t.z = c; t.w = d; return __builtin_bit_cast(bf16x8, t); }
#define MFMA16(a, b, c) __builtin_amdgcn_mfma_f32_16x16x32_bf16((a), (b), (c), 0, 0, 0)
typedef short bf16x4 __attribute__((ext_vector_type(4)));
#define MFMA16K(a, b, c) __builtin_amdgcn_mfma_f32_16x16x16bf16_1k((a), (b), (c), 0, 0, 0)

#define XB_TMO      128
#define XB_XCNT(j)  (256  + 64 * (j))
#define XB_XSUB(j)  (1280 + 64 * (j))
#define XB_XGEN(j)  (2304 + 64 * (j))
#define XB_TOP      3328
#define XB_TOPGEN   3392
#define XCD_BAR_WORDS 3456
#define XB_SPIN_CAP (1u << 18)
__device__ __forceinline__ unsigned xb_ld(unsigned* p)              { return __hip_atomic_load(p, __ATOMIC_RELAXED, __HIP_MEMORY_SCOPE_AGENT); }
__device__ __forceinline__ unsigned xb_add(unsigned* p, unsigned v) { return __hip_atomic_fetch_add(p, v, __ATOMIC_RELAXED, __HIP_MEMORY_SCOPE_AGENT); }
__device__ __forceinline__ unsigned xb_xcc_id() { return (unsigned)__builtin_amdgcn_s_getreg((3 << 11) | 20) & 0xFu; }
#define XB_SPIN(cond, bar) do { unsigned _sp = 0; while (cond) { __builtin_amdgcn_s_sleep(1); \
    if ((++_sp & 255u) == 0u) { if (xb_ld(&(bar)[XB_TMO])) break; if (_sp > XB_SPIN_CAP) { atomicAdd(&(bar)[XB_TMO], 1u); break; } } } } while (0)
struct XcdBarrier { unsigned* bar; unsigned x; volatile LAS unsigned* st; };
__device__ __forceinline__ XcdBarrier xcd_barrier_post(unsigned* bar, volatile LAS unsigned* st) {
    XcdBarrier b; b.bar = bar; b.x = xb_xcc_id(); b.st = st;
    if (threadIdx.x == 0) (void)xb_add(&bar[XB_XCNT(b.x)], 1u);
    return b;
}
__device__ __forceinline__ void xcd_barrier_complete(unsigned* bar, unsigned x, unsigned& nloc, unsigned& nx) {
    const unsigned G = gridDim.x * gridDim.y * gridDim.z;
    unsigned sum, cnt, mine, sp = 0u;
    for (;;) {
        sum = 0u; cnt = 0u; mine = 0u;
#pragma unroll
        for (unsigned j = 0; j < 16; ++j) { const unsigned c = xb_ld(&bar[XB_XCNT(j)]); sum += c; cnt += (c > 0u) ? 1u : 0u; mine = (j == x) ? c : mine; }
        if (sum == G) break;
        __builtin_amdgcn_s_sleep(1);
        if ((++sp & 255u) == 0u) { if (xb_ld(&bar[XB_TMO])) break; if (sp > XB_SPIN_CAP) { atomicAdd(&bar[XB_TMO], 1u); break; } }
    }
    nloc = mine > 0u ? mine : 1u; nx = cnt > 0u ? cnt : 1u;
}
__device__ __forceinline__ void xcd_barrier(const XcdBarrier& b) {
    asm volatile("s_waitcnt vmcnt(0)" ::: "memory");
    __syncthreads();
    if (threadIdx.x == 0) {
        unsigned* bar = b.bar;
        __builtin_amdgcn_s_waitcnt(0);
        unsigned nloc = b.st[0], nx = b.st[1];
        if (nloc == 0u) { xcd_barrier_complete(bar, b.x, nloc, nx); b.st[0] = nloc; b.st[1] = nx; }
        const unsigned old = xb_add(&bar[XB_XSUB(b.x)], 1u);
        const unsigned gen = old / nloc;
        if (old + 1u == (gen + 1u) * nloc) {
            __builtin_amdgcn_fence(__ATOMIC_RELEASE, "agent");
            asm volatile("s_waitcnt vmcnt(0)" ::: "memory");
            const unsigned og = xb_add(&bar[XB_TOP], 1u);
            const unsigned tg = og / nx;
            if (og + 1u == (tg + 1u) * nx) xb_add(&bar[XB_TOPGEN], 1u);
            else XB_SPIN(xb_ld(&bar[XB_TOPGEN]) == tg, bar);
            __builtin_amdgcn_fence(__ATOMIC_ACQUIRE, "agent");
            xb_add(&bar[XB_XGEN(b.x)], 1u);
            asm volatile("s_waitcnt vmcnt(0)" ::: "memory");
        } else {
            XB_SPIN(xb_ld(&bar[XB_XGEN(b.x)]) == gen, bar);
            __builtin_amdgcn_fence(__ATOMIC_ACQUIRE, "agent");
            asm volatile("s_waitcnt vmcnt(0)" ::: "memory");
        }
    }
    __syncthreads();
}

struct Args { const float* in[25]; float* out; unsigned char* ws; int ph_lo, ph_hi, bar_idx, pad; };
enum { I_X = 0, I_WIN, I_LAMRE, I_LAMIM, I_LOGDT, I_BRE, I_BIM, I_CRE, I_CIM, I_S5D, I_WGLU, I_BGLU, I_GWG, I_GBG, I_GNW, I_LBL, I_HNW, I_WUP, I_WOUT, I_LN1G, I_LN1B, I_LN2G, I_LN2B, I_W1, I_W2 };

__device__ __forceinline__ void cvt_item(const float* src, int ld_src, int c0, bf16* dst, int ld_dst, int row_off, int koff, int nblk, int item, LAS float* scr, int lane) {
    const int kb = item / nblk, nb = item % nblk, k0 = 64 * kb, n0 = 32 * nb;
    {
        const int kr = lane >> 3, q = lane & 7; const GAS float* sp = (const GAS float*)src + (size_t)(k0 + kr) * ld_src + c0 + n0 + 4 * q;
        f32x4 v[8];
#pragma unroll
        for (int i = 0; i < 8; ++i) v[i] = *(const GAS f32x4*)(sp + (size_t)(8 * i) * ld_src);
#pragma unroll
        for (int i = 0; i < 8; ++i) *(LAS f32x4*)(scr + (8 * i + kr) * 36 + 4 * q) = v[i];
    }
    LDS_WAIT(); asm volatile("" ::: "memory");
    const int c = lane & 7;
#pragma unroll
    for (int j = 0; j < 4; ++j) { const int n = (lane >> 3) + 8 * j; const LAS float* s = scr + (8 * c) * 36 + n;
        v4u o; o.x = pk2(s[0 * 36], s[1 * 36]); o.y = pk2(s[2 * 36], s[3 * 36]); o.z = pk2(s[4 * 36], s[5 * 36]); o.w = pk2(s[6 * 36], s[7 * 36]);
        *(GAS v4u*)(dst + (size_t)(row_off + n0 + n) * ld_dst + koff + k0 + 8 * c) = o; }
    LDS_WAIT(); asm volatile("" ::: "memory");
}

__device__ __forceinline__ void ln_phase(const bf16* Y, const float* g, const float* b, float* out, bf16* xb, float* st, int gw, int NGW, int lane) {
    v4u nv[4];
    if (gw < M) { const GAS v4u* yr = (const GAS v4u*)(Y + (size_t)gw * D) + lane;
#pragma unroll
        for (int j = 0; j < 4; ++j) nv[j] = yr[64 * j]; }
    for (int m = gw; m < M; m += NGW) {
        f32x4 v[8]; float s = 0.f;
#pragma unroll
        for (int j = 0; j < 4; ++j) { const f32x2_t a = unpk_h(nv[j].x), b2 = unpk_h(nv[j].y), c = unpk_h(nv[j].z), d = unpk_h(nv[j].w); v[2 * j] = (f32x4){a.x, a.y, b2.x, b2.y}; v[2 * j + 1] = (f32x4){c.x, c.y, d.x, d.y}; }
        { const int mn = m + NGW < M ? m + NGW : m; const GAS v4u* yr = (const GAS v4u*)(Y + (size_t)mn * D) + lane;
#pragma unroll
          for (int j = 0; j < 4; ++j) nv[j] = yr[64 * j]; }
#pragma unroll
        for (int j = 0; j < 8; ++j) s += (v[j][0] + v[j][1]) + (v[j][2] + v[j][3]);
        const float mean = wave_sum(s) * (1.0f / D); float s2 = 0.f;
#pragma unroll
        for (int j = 0; j < 8; ++j) { v[j] = v[j] - mean; s2 += (v[j][0] * v[j][0] + v[j][1] * v[j][1]) + (v[j][2] * v[j][2] + v[j][3] * v[j][3]); }
        const float rstd = rsqrtf(wave_sum(s2) * (1.0f / D) + LN_EPS);
        if (out) {
            GAS f32x4* orow = (GAS f32x4*)(out + (size_t)m * D) + 2 * lane;
#pragma unroll
            for (int j = 0; j < 8; ++j) { const int c4 = 2 * lane + 128 * (j >> 1) + (j & 1); const f32x4 gg = ((const f32x4*)g)[c4], bb = ((const f32x4*)b)[c4]; orow[128 * (j >> 1) + (j & 1)] = v[j] * rstd * gg + bb; }
        } else {
            if (lane == 0) { st[2 * (size_t)m] = mean; st[2 * (size_t)m + 1] = rstd; }
            GAS v4u* o16 = (GAS v4u*)(xb + (size_t)m * D) + lane;
#pragma unroll
            for (int j = 0; j < 4; ++j) { const int c4 = 2 * lane + 128 * j; const f32x4 g0 = ((const f32x4*)g)[c4], b0 = ((const f32x4*)b)[c4], g1 = ((const f32x4*)g)[c4 + 1], b1 = ((const f32x4*)b)[c4 + 1];
                const f32x4 o0 = v[2 * j] * rstd * g0 + b0, o1 = v[2 * j + 1] * rstd * g1 + b1;
                v4u w; w.x = cvtpk(o0[0], o0[1]); w.y = cvtpk(o0[2], o0[3]); w.z = cvtpk(o1[0], o1[1]); w.w = cvtpk(o1[2], o1[3]);
                o16[64 * j] = w; }
        }
    }
}

__device__ __forceinline__ void cpow_(double revd, float lrdt, int m, float& re, float& im) {
    double a = revd * (double)m; a -= rint(a);
    const float mag = __expf(lrdt * (float)m), af = (float)a; re = mag * __builtin_amdgcn_cosf(af); im = mag * __builtin_amdgcn_sinf(af);
}
__device__ __forceinline__ void s5_build(const Args& args, int l, int g, bf16* WgT, bf16* TQ, float* S5C, LAS unsigned char* lds, int tid) {
    LAS double* angd = (LAS double*)lds;
    LAS float* lrdt = (LAS float*)(lds + 512);
    LAS float* bbr = lrdt + 64;
    LAS float* bbi = bbr + 1024;
    LAS float* car = bbi + 1024;
    LAS float* cai = car + 1024;
    LAS float* ktab = cai + 1024;
    __syncthreads();
    if (tid < 64) {
        const int p = tid;
        const float lr = fminf(args.in[I_LAMRE][(l * 64 + g) * 64 + p], -1e-4f), li = args.in[I_LAMIM][(l * 64 + g) * 64 + p];
        const float dt = expf(args.in[I_LOGDT][l * 64 + g]);
        const double rev = (double)li * (double)dt * 0.15915494309189533577;
        angd[p] = rev; lrdt[p] = lr * dt;
        float ar, ai; cpow_(rev, lr * dt, 1, ar, ai);
        const float den = lr * lr + li * li;
        const float fre = ((ar - 1.0f) * lr + ai * li) / den, fim = (ai * lr - (ar - 1.0f) * li) / den;
#pragma unroll
        for (int c = 0; c < 16; ++c) { const float br = args.in[I_BRE][((size_t)(l * 64 + g) * 64 + p) * 16 + c], bi = args.in[I_BIM][((size_t)(l * 64 + g) * 64 + p) * 16 + c];
            bbr[p * 16 + c] = fre * br - fim * bi; bbi[p * 16 + c] = fre * bi + fim * br; }
        float r16, i16, r512, i512; cpow_(rev, lr * dt, 16, r16, i16); cpow_(rev, lr * dt, 512, r512, i512);
        S5C[p] = r16; S5C[64 + p] = i16; S5C[128 + p] = r512; S5C[192 + p] = i512;
    }
    __syncthreads();
    {
        const int p = tid & 63, jj = tid >> 6;
#pragma unroll
        for (int h = 0; h < 2; ++h) { const int j = jj + 8 * h; float pr, pi; cpow_(angd[p], lrdt[p], 15 - j, pr, pi);
            unsigned wr[8], wi[8];
#pragma unroll
            for (int c = 0; c < 16; c += 2) { const float r0 = pr * bbr[p * 16 + c] - pi * bbi[p * 16 + c], i0 = pr * bbi[p * 16 + c] + pi * bbr[p * 16 + c];
                const float r1 = pr * bbr[p * 16 + c + 1] - pi * bbi[p * 16 + c + 1], i1 = pr * bbi[p * 16 + c + 1] + pi * bbr[p * 16 + c + 1];
                wr[c >> 1] = pk2(r0, r1); wi[c >> 1] = pk2(i0, i1); }
            v4u* dr = (v4u*)(WgT + (size_t)p * 256 + j * 16); v4u* di = (v4u*)(WgT + (size_t)(64 + p) * 256 + j * 16);
            v4u t; t.x = wr[0]; t.y = wr[1]; t.z = wr[2]; t.w = wr[3]; dr[0] = t; t.x = wr[4]; t.y = wr[5]; t.z = wr[6]; t.w = wr[7]; dr[1] = t;
            t.x = wi[0]; t.y = wi[1]; t.z = wi[2]; t.w = wi[3]; di[0] = t; t.x = wi[4]; t.y = wi[5]; t.z = wi[6]; t.w = wi[7]; di[1] = t; }
    }
    for (int tau = 0; tau <= 16; ++tau) {
        __syncthreads();
#pragma unroll
        for (int h = 0; h < 2; ++h) { const int e = tid + 512 * h, c = e >> 6, p = e & 63;
            float pr, pi; cpow_(angd[p], lrdt[p], tau, pr, pi);
            const float cr = args.in[I_CRE][((size_t)(l * 64 + g) * 16 + c) * 64 + p], ci = args.in[I_CIM][((size_t)(l * 64 + g) * 16 + c) * 64 + p];
            const float mr = cr * pr - ci * pi, mi = cr * pi + ci * pr;
            car[e] = mr; cai[e] = mi;
            if (tau >= 1) { const int n = (tau - 1) * 16 + c; TQ[(size_t)n * 384 + 256 + p] = (bf16)f2bf(mr); TQ[(size_t)n * 384 + 320 + p] = (bf16)f2bf(-mi); } }
        __syncthreads();
        if (tau < 16 && tid < 256) { const int c = tid >> 4, c2 = tid & 15; float s = 0.f;
            for (int p = 0; p < 64; ++p) s += car[c * 64 + p] * bbr[p * 16 + c2] - cai[c * 64 + p] * bbi[p * 16 + c2];
            ktab[tau * 256 + c * 16 + c2] = s; }
    }
    __syncthreads();
    {
        const int n = tid >> 1, i = n >> 4, c = n & 15, hf = tid & 1;
#pragma unroll
        for (int jj = 0; jj < 8; ++jj) { const int j = hf * 8 + jj; unsigned w[8];
#pragma unroll
            for (int c2 = 0; c2 < 16; c2 += 2) { float a = 0.f, b = 0.f; if (i >= j) { a = ktab[(i - j) * 256 + c * 16 + c2]; b = ktab[(i - j) * 256 + c * 16 + c2 + 1]; } w[c2 >> 1] = pk2(a, b); }
            v4u* d = (v4u*)(TQ + (size_t)n * 384 + j * 16); v4u t; t.x = w[0]; t.y = w[1]; t.z = w[2]; t.w = w[3]; d[0] = t; t.x = w[4]; t.y = w[5]; t.z = w[6]; t.w = w[7]; d[1] = t; }
    }
    __syncthreads();
}

constexpr int S5_VS = 132;
constexpr int S5_WROW = 528, S5_TROW = 784;
__device__ __forceinline__ float gelu_fast(float x) { return x * sigm(1.5957691216057308f * (x + 0.044715f * x * x * x)); }
__device__ __forceinline__ void s5_unit(const bf16* Ubg, const bf16* WgT, const bf16* TQ, const float* S5C, const float* dsk, bf16* Zbg, LAS unsigned char* lds, int tid) {
    const int lane = tid & 63, wave = __builtin_amdgcn_readfirstlane(tid >> 6), r = lane & 15, kg = lane >> 4;
    LAS float* V = (LAS float*)lds; LAS float* CAR = V + 256 * S5_VS;
    __syncthreads();
    { const unsigned char* gsrc = (const unsigned char*)WgT + (size_t)(tid >> 5) * 512 + (tid & 31) * 16; LAS unsigned char* ldst = lds + (tid >> 5) * S5_WROW + (tid & 31) * 16;
#pragma unroll
      for (int i = 0; i < 8; ++i) *(LAS v4u*)(ldst + i * 16 * S5_WROW) = *(const v4u*)(gsrc + i * 16 * 512); }
    bf16x8 ua[2][8];
#pragma unroll
    for (int mt = 0; mt < 2; ++mt)
#pragma unroll
        for (int ks = 0; ks < 8; ++ks) ua[mt][ks] = *(const bf16x8*)(Ubg + (size_t)(32 * wave + 16 * mt + r) * 256 + 32 * ks + 8 * kg);
    __syncthreads();
    {
        f32x4 acc[2][8];
#pragma unroll
        for (int mt = 0; mt < 2; ++mt)
#pragma unroll
            for (int nt = 0; nt < 8; ++nt) acc[mt][nt] = (f32x4){0.f, 0.f, 0.f, 0.f};
#pragma unroll
        for (int ks = 0; ks < 8; ++ks)
#pragma unroll
            for (int nt = 0; nt < 8; ++nt) { const bf16x8 b = *(const LAS bf16x8*)(lds + (16 * nt + r) * S5_WROW + ks * 64 + kg * 16);
#pragma unroll
                for (int mt = 0; mt < 2; ++mt) acc[mt][nt] = MFMA16(b, ua[mt][ks], acc[mt][nt]);
                if (nt == 7) __builtin_amdgcn_sched_barrier(0); }
        __syncthreads();
#pragma unroll
        for (int mt = 0; mt < 2; ++mt)
#pragma unroll
            for (int nt = 0; nt < 8; ++nt) *(LAS f32x4*)(V + (32 * wave + 16 * mt + r) * S5_VS + 16 * nt + 4 * kg) = acc[mt][nt];
    }
    bf16x8 sa[2][4];
    {
        const float a16r = S5C[lane], a16i = S5C[64 + lane], a5r = S5C[128 + lane], a5i = S5C[192 + lane];
        asm volatile("s_waitcnt lgkmcnt(0)" ::: "memory");
        float vr[32], vi[32];
#pragma unroll
        for (int q = 0; q < 32; ++q) { vr[q] = V[(32 * wave + q) * S5_VS + lane]; vi[q] = V[(32 * wave + q) * S5_VS + 64 + lane]; }
        float sr = 0.f, si = 0.f;
#pragma unroll
        for (int q = 0; q < 32; ++q) { const float tr = vr[q], ti = vi[q]; vr[q] = sr; vi[q] = si; const float nr = a16r * sr - a16i * si + tr, ni = a16r * si + a16i * sr + ti; sr = nr; si = ni; }
        CAR[wave * 128 + lane] = sr; CAR[wave * 128 + 64 + lane] = si;
        __syncthreads();
        float cr = 0.f, ci = 0.f;
        for (int w2 = 0; w2 < wave; ++w2) { const float er = CAR[w2 * 128 + lane], ei = CAR[w2 * 128 + 64 + lane]; const float nr = a5r * cr - a5i * ci + er, ni = a5r * ci + a5i * cr + ei; cr = nr; ci = ni; }
        float pr = 1.f, pi = 0.f;
        LAS bf16* SP = (LAS bf16*)lds;
#pragma unroll
        for (int q = 0; q < 32; ++q) { const float xr = vr[q] + pr * cr - pi * ci, xi = vi[q] + pr * ci + pi * cr;
            SP[(32 * wave + q) * 264 + lane] = (bf16)f2bf(xr); SP[(32 * wave + q) * 264 + 64 + lane] = (bf16)f2bf(xi);
            const float nr = pr * a16r - pi * a16i, ni = pr * a16i + pi * a16r; pr = nr; pi = ni; }
        asm volatile("s_waitcnt lgkmcnt(0)" ::: "memory");
#pragma unroll
        for (int mt = 0; mt < 2; ++mt)
#pragma unroll
            for (int k2 = 0; k2 < 4; ++k2) sa[mt][k2] = *(const LAS bf16x8*)(lds + (32 * wave + 16 * mt + r) * S5_WROW + k2 * 64 + kg * 16);
    }
    const f32x4 dv = *(const f32x4*)(dsk + 4 * kg);
#pragma unroll 1
    for (int nh = 0; nh < 2; ++nh) {
        asm volatile("s_waitcnt lgkmcnt(0)" ::: "memory");
        __syncthreads();
        { const unsigned char* gsrc = (const unsigned char*)TQ + (size_t)(128 * nh + (tid >> 2)) * 768 + (tid & 3) * 192; LAS unsigned char* ldst = lds + (tid >> 2) * S5_TROW + (tid & 3) * 192;
#pragma unroll
          for (int i = 0; i < 12; ++i) *(LAS v4u*)(ldst + i * 16) = *(const v4u*)(gsrc + i * 16); }
        __syncthreads();
        f32x4 acc[2][8];
#pragma unroll
        for (int mt = 0; mt < 2; ++mt)
#pragma unroll
            for (int nt = 0; nt < 8; ++nt) acc[mt][nt] = (f32x4){0.f, 0.f, 0.f, 0.f};
#pragma unroll
        for (int ks = 0; ks < 12; ++ks)
#pragma unroll
            for (int nt = 0; nt < 8; ++nt) { const bf16x8 b = *(const LAS bf16x8*)(lds + (16 * nt + r) * S5_TROW + ks * 64 + kg * 16);
#pragma unroll
                for (int mt = 0; mt < 2; ++mt) acc[mt][nt] = MFMA16(b, ks < 8 ? ua[mt][ks < 8 ? ks : 0] : sa[mt][ks < 8 ? 0 : ks - 8], acc[mt][nt]);
                if (nt == 7) __builtin_amdgcn_sched_barrier(0); }
#pragma unroll
        for (int mt = 0; mt < 2; ++mt)
#pragma unroll
            for (int nt = 0; nt < 8; ++nt) { const int i = 8 * nh + nt, kb = 32 * wave + 16 * mt + r, s = 16 * kb + i;
                const v2u uu = *(const v2u*)(Ubg + (size_t)s * 16 + 4 * kg);
                const f32x4 a = acc[mt][nt];
                const float y0 = a[0] + dv[0] * bflo(uu.x), y1 = a[1] + dv[1] * bfhi(uu.x), y2 = a[2] + dv[2] * bflo(uu.y), y3 = a[3] + dv[3] * bfhi(uu.y);
                v2u o; o.x = cvtpk(gelu_fast(y0), gelu_fast(y1)); o.y = cvtpk(gelu_fast(y2), gelu_fast(y3));
                *(v2u*)(Zbg + (size_t)s * BW + 4 * kg) = o; }
    }
    __syncthreads();
}

__device__ __forceinline__ void glow_tile(const bf16* XB, const bf16* WglowT, float* GLOW, int row0, int lane) {
    const int r = lane & 15, kg = lane >> 4;
    f32x4 acc = (f32x4){0.f, 0.f, 0.f, 0.f};
#pragma unroll 16
    for (int ks = 0; ks < D / 32; ++ks) {
        const bf16x8 a = *(const bf16x8*)(XB + (size_t)(row0 + r) * D + 32 * ks + 8 * kg);
        const bf16x8 b = *(const bf16x8*)(WglowT + (size_t)r * D + 32 * ks + 8 * kg);
        acc = MFMA16(a, b, acc);
    }
#pragma unroll
    for (int j = 0; j < 4; ++j) GLOW[(size_t)(row0 + 4 * kg + j) * 16 + r] = acc[j];
}

__device__ __forceinline__ int kperm(int kk) { const int o = kk & 31; return (kk & ~31) + 8 * ((o >> 2) & 3) + 4 * (o >> 4) + (o & 3); }

constexpr int PRP_INB = 36864, PRP_Q = 0, PRP_K = 16384, PRP_G = 32768, PRP_OUT = 2 * PRP_INB, PRP_KD = PRP_OUT + 2 * BND_BYTES, PRP_QU = PRP_KD + 4 * 16 * BND_ROW, PRP_GLX = PRP_QU + 2 * 16 * BND_ROW;
__device__ __forceinline__ void prep_dma(int u, int p, const bf16* H, const float* GLOW, LAS unsigned char* lds, int tid) {
    const int bhx = u >> 6, grp = u & 63; const bool gla = bhx < 16;
    const int b = gla ? (bhx >> 2) : ((bhx - 16) >> 3), h = gla ? (bhx & 3) : ((bhx - 16) & 7);
    const size_t row0 = (size_t)b * SEQ + (size_t)grp * 64;
    const int qcol = gla ? (HC_GQ + h * 128) : (HC_HQ + h * 128), kcol = gla ? (HC_GK + h * 128) : (HC_HF + h * 128);
    const int lane = tid & 63, w = __builtin_amdgcn_readfirstlane(tid >> 6), rl = lane >> 3, c8 = lane & 7;
    const bf16* hq = H + (row0 + 8 * w + rl) * NH;
    LAS unsigned char* dst = lds + p * PRP_INB;
#pragma unroll
    for (int j = 0; j < 2; ++j) {
        __builtin_amdgcn_global_load_lds((const unsigned*)(hq + qcol + (c8 + 8 * j) * 8), (LAS unsigned*)(dst + PRP_Q + j * 8192 + w * 1024), 16, 0, 0);
        __builtin_amdgcn_global_load_lds((const unsigned*)(hq + kcol + (c8 + 8 * j) * 8), (LAS unsigned*)(dst + PRP_K + j * 8192 + w * 1024), 16, 0, 0); }
    if (w < 4) __builtin_amdgcn_global_load_lds((const unsigned*)(GLOW + (row0 + 16 * w + (lane >> 2)) * 16 + (lane & 3) * 4), (LAS unsigned*)(dst + PRP_G + w * 1024), 16, 0, 0);
}
__device__ __forceinline__ void prep_unit(const Args& args, int l, int u, int unext, int p, const bf16* H, const float* GLOW, unsigned char* BND, LAS unsigned char* lds, int tid) {
    const int bhx = u >> 6, grp = u & 63, kk = tid & 127, bl = tid >> 7;
    const bool gla = bhx < 16;
    const int h = gla ? (bhx & 3) : ((bhx - 16) & 7);
    asm volatile("s_waitcnt vmcnt(0)" ::: "memory");
    __syncthreads();
    if (unext < 48 * 64) prep_dma(unext, p ^ 1, H, GLOW, lds, tid);
    const LAS unsigned char* inb = lds + p * PRP_INB;
    float q[16], k[16], G[16];
    const LAS bf16* sq = (const LAS bf16*)(inb + PRP_Q + (kk >> 6) * 8192) + (16 * bl) * 64 + (kk & 63); const LAS bf16* sk = (const LAS bf16*)(inb + PRP_K + (kk >> 6) * 8192) + (16 * bl) * 64 + (kk & 63);
    if (gla) {
        float wg[16];
#pragma unroll
        for (int r = 0; r < 16; ++r) wg[r] = args.in[I_GWG][((size_t)l * 16 + r) * 512 + h * 128 + kk];
        const float bg = args.in[I_GBG][l * 512 + h * 128 + kk];
        float run = 0.f;
#pragma unroll
        for (int i = 0; i < 16; ++i) { const LAS f32x4* gp = (const LAS f32x4*)(inb + PRP_G + (16 * bl + i) * 64); float z = bg;
#pragma unroll
            for (int r4 = 0; r4 < 4; ++r4) { const f32x4 gv = gp[r4]; z += gv[0] * wg[4 * r4] + gv[1] * wg[4 * r4 + 1] + gv[2] * wg[4 * r4 + 2] + gv[3] * wg[4 * r4 + 3]; }
            const float ls = fminf(z, 0.f) - __logf(1.0f + __expf(-fabsf(z)));
            run += fmaxf(ls * (1.0f / 16.0f), -100.f); G[i] = run;
            q[i] = bf2f(sq[i * 64]) * 0.08838834764831845f; k[i] = bf2f(sk[i * 64]); }
    } else {
        float lbv;
        { float lg[4], mx = -1e30f;
#pragma unroll
          for (int t = 0; t < 4; ++t) { lg[t] = args.in[I_LBL][t * 1024 + h * 128 + kk]; mx = fmaxf(mx, lg[t]); }
          float e[4], se = 0.f;
#pragma unroll
          for (int t = 0; t < 4; ++t) { e[t] = __expf(lg[t] - mx); se += e[t]; }
          float cs = 0.f;
#pragma unroll
          for (int t = 1; t < 4; ++t) if (t <= l) cs += e[t] / se;
          lbv = cs; }
        float run = 0.f;
#pragma unroll
        for (int i = 0; i < 16; ++i) { const float fl = bf2f(sk[i * 64]); const float f = lbv + (1.0f - lbv) * sigm(fl);
            run += fmaxf(__logf(f), -100.f); G[i] = run; k[i] = 1.0f - f;
            const float qv = bf2f(sq[i * 64]); q[i] = qv * sigm(qv); }
    }
    const int pr = bl >> 1, hf = bl & 1;
    LAS unsigned char* img = lds + PRP_OUT + pr * BND_BYTES; LAS unsigned char* kds = lds + PRP_KD + bl * (16 * BND_ROW); LAS unsigned char* qus = lds + PRP_QU + pr * (16 * BND_ROW);
    LAS float* glx = (LAS float*)(lds + PRP_GLX);
    const int pos = kperm(kk);
    const float Gl = G[15], GLs = __expf(Gl);
    glx[bl * 128 + kk] = GLs;
    __syncthreads();
    const float GLp = glx[(bl ^ 1) * 128 + kk];
    unsigned kh[8];
#pragma unroll
    for (int i = 0; i < 16; i += 2) {
        const float E0 = __expf(fmaxf(G[i], -80.f)), E1 = __expf(fmaxf(G[i + 1], -80.f));
        const float R0 = __builtin_amdgcn_rcpf(E0), R1 = __builtin_amdgcn_rcpf(E1);
        const float q0 = q[i] * E0, q1 = q[i + 1] * E1;
        *(LAS bf16*)(img + BND_Q2 + (16 * hf + i) * BND_ROW + pos * 2) = (bf16)f2bf(hf ? q0 * GLp : q0);
        *(LAS bf16*)(img + BND_Q2 + (16 * hf + i + 1) * BND_ROW + pos * 2) = (bf16)f2bf(hf ? q1 * GLp : q1);
        if (hf) { *(LAS bf16*)(qus + i * BND_ROW + pos * 2) = (bf16)f2bf(q0); *(LAS bf16*)(qus + (i + 1) * BND_ROW + pos * 2) = (bf16)f2bf(q1); }
        *(LAS bf16*)(kds + i * BND_ROW + pos * 2) = (bf16)f2bf(k[i] * R0);
        *(LAS bf16*)(kds + (i + 1) * BND_ROW + pos * 2) = (bf16)f2bf(k[i + 1] * R1);
        const float h0 = k[i] * __expf(Gl - G[i]), h1 = k[i + 1] * __expf(Gl - G[i + 1]);
        kh[i >> 1] = hf ? pk2(h0, h1) : pk2(h0 * GLp, h1 * GLp);
    }
    { LAS unsigned char* d = img + BND_K2T + kk * 64; const int hs = (-(kk >> 2)) & 3; v4u t; t.x = kh[0]; t.y = kh[1]; t.z = kh[2]; t.w = kh[3]; *(LAS v4u*)(d + ((2 * hf) ^ hs) * 16) = t; t.x = kh[4]; t.y = kh[5]; t.z = kh[6]; t.w = kh[7]; *(LAS v4u*)(d + ((2 * hf + 1) ^ hs) * 16) = t; }
    if (hf == 0) *(LAS float*)(img + BND_GL + kk * 4) = GLs * GLp;
    { unsigned z0 = 0u; asm volatile("" : "+v"(z0));
      if (kk < 16) *(LAS v4u*)(img + BND_Q2 + (16 * hf + kk) * BND_ROW + 256) = (v4u){z0, z0, z0, z0};
      if (hf == 0 && kk < 16) { const int hs = (-(kk >> 2)) & 3; *(LAS v4u*)(img + BND_A2 + kk * 64 + (2 ^ hs) * 16) = (v4u){z0, z0, z0, z0}; *(LAS v4u*)(img + BND_A2 + kk * 64 + (3 ^ hs) * 16) = (v4u){z0, z0, z0, z0}; }
      if (hf == 1 && kk < 64) *(LAS v4u*)(img + BND_A2 + 2048 + kk * 16) = (v4u){z0, z0, z0, z0}; }
    __syncthreads();
    if (tid < 384) {
        const int w = tid >> 6, lane = tid & 63, r = lane & 15, kg = lane >> 4, p2 = w / 3, wh = w - 3 * p2;
        LAS unsigned char* im = lds + PRP_OUT + p2 * BND_BYTES;
        const LAS unsigned char* qsrc = wh == 0 ? im + BND_Q2 : wh == 1 ? im + BND_Q2 + 16 * BND_ROW : lds + PRP_QU + p2 * (16 * BND_ROW);
        const LAS unsigned char* kd = lds + PRP_KD + (2 * p2 + (wh == 2 ? 1 : 0)) * (16 * BND_ROW);
        f32x4 At = (f32x4){0.f, 0.f, 0.f, 0.f}, At2 = (f32x4){0.f, 0.f, 0.f, 0.f};
#pragma unroll
        for (int ks = 0; ks < 4; ++ks) { const bf16x8 qf = *(const LAS bf16x8*)(qsrc + r * BND_ROW + ks * 64 + kg * 16), kf = *(const LAS bf16x8*)(kd + r * BND_ROW + ks * 64 + kg * 16);
            if (ks & 1) At2 = MFMA16(kf, qf, At2); else At = MFMA16(kf, qf, At); }
        At = At + At2;
        if (wh != 1) {
#pragma unroll
            for (int j = 0; j < 4; ++j) if (4 * kg + j > r) At[j] = 0.f; }
        v2u ab; ab.x = cvtpk(At[0], At[1]); ab.y = cvtpk(At[2], At[3]);
        *(LAS v2u*)(im + BND_A2 + ((wh == 0 ? 0 : 16) + r) * 64 + ((((wh == 2 ? 2 : 0) + (kg >> 1)) ^ ((-(r >> 2)) & 3)) * 16) + (kg & 1) * 8) = ab;
    }
    __syncthreads();
    {
        unsigned char* dst = BND + ((size_t)bhx * NPAIR + grp * 2) * BND_BYTES;
#pragma unroll
        for (int i = 0; i < 2 * BND_BYTES / 16 / 512; ++i) { const int c = tid + 512 * i; *(GAS v4u*)(dst + c * 16) = *(const LAS v4u*)(lds + PRP_OUT + c * 16); }
    }
}

__device__ __forceinline__ void rec_unit(int u, const unsigned char* BND, const bf16* H, bf16* YCAT, LAS unsigned char* lds, int tid) {
    const int lane = tid & 63, wave = __builtin_amdgcn_readfirstlane(tid >> 6), r = lane & 15, kg = lane >> 4;
    const bool gla = u < 64;
    const int bh = gla ? (u >> 2) : ((u - 64) >> 1), dvg = gla ? (u & 3) : ((u - 64) & 1), bhx = gla ? bh : 16 + bh;
    const int b = gla ? (bh >> 2) : (bh >> 3), h = gla ? (bh & 3) : (bh & 7);
    const unsigned char* bnd = BND + (size_t)bhx * NPAIR * BND_BYTES;
    const bf16* vsrc = H + (size_t)b * SEQ * NH + (gla ? HC_GV + h * 256 : HC_HI + h * 128) + dvg * 64;
    const int ocol = (gla ? BW + h * 256 : 2 * BW + h * 128) + dvg * 64;
#define REC_BAR() do { asm volatile("" ::: "memory"); __builtin_amdgcn_s_barrier(); asm volatile("" ::: "memory"); } while (0)
    __syncthreads();
    if (wave >= 4) {
        const int lw = wave - 4;
        constexpr int RDEPTH = 4;
        const GAS unsigned char* gsrc[6]; int lofs[6]; size_t gstep[6];
#pragma unroll
        for (int q = 0; q < 6; ++q) { const int p = lw + 4 * q; lofs[q] = p * 1024 + lane * 16;
            gsrc[q] = (const GAS unsigned char*)(p < 20 ? bnd + p * 1024 + lane * 16 : (const unsigned char*)(vsrc + (size_t)(8 * (p - 20) + (lane >> 3)) * NH) + (lane & 7) * 16); gstep[q] = p < 20 ? (size_t)BND_BYTES : (size_t)32 * NH * 2; }
        v4u buf[RDEPTH][6];
#define REC_LOAD(j, pr_) do { const int pq = (pr_) < NPAIR ? (pr_) : NPAIR - 1; _Pragma("unroll") for (int q = 0; q < 6; ++q) { const GAS unsigned char* p_ = gsrc[q] + (size_t)pq * gstep[q]; \
            asm volatile("global_load_dwordx4 %0, %1, off" : "=v"(buf[j][q]) : "v"(p_) : "memory"); } } while (0)
#define REC_WRITE(j, pr_) do { asm volatile("s_waitcnt vmcnt(18)" : "+v"(buf[j][0]), "+v"(buf[j][1]), "+v"(buf[j][2]), "+v"(buf[j][3]), "+v"(buf[j][4]), "+v"(buf[j][5]) :: "memory"); \
            LAS unsigned char* slot = lds + ((pr_) % 3) * SLOT_BYTES; _Pragma("unroll") for (int q = 0; q < 6; ++q) *(LAS v4u*)(slot + lofs[q]) = buf[j][q]; } while (0)
#pragma unroll
        for (int j = 0; j < RDEPTH; ++j) REC_LOAD(j, j);
        REC_WRITE(0, 0); REC_LOAD(0, RDEPTH); REC_WRITE(1, 1); REC_LOAD(1, RDEPTH + 1);
        asm volatile("s_waitcnt lgkmcnt(0)" ::: "memory");
        REC_BAR();
        for (int n = 0; n < NPAIR; n += RDEPTH) {
#pragma unroll
            for (int j = 0; j < RDEPTH; ++j) { const int m = n + j;
                REC_WRITE((j + 2) % RDEPTH, m + 2); REC_LOAD((j + 2) % RDEPTH, m + 2 + RDEPTH);
                asm volatile("s_waitcnt lgkmcnt(0)" ::: "memory");
                REC_BAR(); }
        }
        asm volatile("s_waitcnt vmcnt(0)" : "+v"(buf[0][0]), "+v"(buf[0][1]), "+v"(buf[0][2]), "+v"(buf[0][3]), "+v"(buf[0][4]), "+v"(buf[0][5]), "+v"(buf[1][0]), "+v"(buf[1][1]), "+v"(buf[1][2]), "+v"(buf[1][3]), "+v"(buf[1][4]), "+v"(buf[1][5]),
                                            "+v"(buf[2][0]), "+v"(buf[2][1]), "+v"(buf[2][2]), "+v"(buf[2][3]), "+v"(buf[2][4]), "+v"(buf[2][5]), "+v"(buf[3][0]), "+v"(buf[3][1]), "+v"(buf[3][2]), "+v"(buf[3][3]), "+v"(buf[3][4]), "+v"(buf[3][5]) :: "memory");
#undef REC_LOAD
#undef REC_WRITE
    } else {
        f32x4 S[8]; const int ksw = kg ^ ((-(r >> 2)) & 3);
#pragma unroll
        for (int kt = 0; kt < 8; ++kt) S[kt] = (f32x4){0.f, 0.f, 0.f, 0.f};
        REC_BAR();
        for (int n = 0; n < NPAIR; ++n) {
            const LAS unsigned char* base = lds + (n % 3) * SLOT_BYTES;
            bf16x8 qf[2][4], af[2], kf[8]; f32x4 gl[8];
#pragma unroll
            for (int tt = 0; tt < 2; ++tt) {
#pragma unroll
                for (int ks = 0; ks < 4; ++ks) qf[tt][ks] = *(const LAS bf16x8*)(base + BND_Q2 + (16 * tt + r) * BND_ROW + ks * 64 + kg * 16);
                af[tt] = *(const LAS bf16x8*)(base + BND_A2 + (16 * tt + r) * 64 + ksw * 16); }
            unsigned vw[4];
            { const LAS bf16* vp = (const LAS bf16*)(base + SLOT_VT) + (8 * kg) * 64 + 16 * wave + r;
#pragma unroll
              for (int j = 0; j < 4; ++j) vw[j] = (unsigned)vp[(2 * j) * 64] | ((unsigned)vp[(2 * j + 1) * 64] << 16); }
            const bf16x8 vf = mk8(vw[0], vw[1], vw[2], vw[3]);
#pragma unroll
            for (int kt = 0; kt < 8; ++kt) { kf[kt] = *(const LAS bf16x8*)(base + BND_K2T + (16 * kt + r) * 64 + ksw * 16); gl[kt] = *(const LAS f32x4*)(base + BND_GL + (16 * kt + 4 * kg) * 4); }
            bf16x8 sf[4];
#pragma unroll
            for (int ks = 0; ks < 4; ++ks) { const f32x4 s0 = S[2 * ks], s1 = S[2 * ks + 1]; sf[ks] = mk8(cvtpk(s0[0], s0[1]), cvtpk(s0[2], s0[3]), cvtpk(s1[0], s1[1]), cvtpk(s1[2], s1[3])); }
            f32x4 o0 = MFMA16(vf, af[0], ((f32x4){0.f, 0.f, 0.f, 0.f})), o1 = MFMA16(vf, af[1], ((f32x4){0.f, 0.f, 0.f, 0.f}));
#pragma unroll
            for (int ks = 0; ks < 4; ++ks) { o0 = MFMA16(sf[ks], qf[0][ks], o0); o1 = MFMA16(sf[ks], qf[1][ks], o1); }
#pragma unroll
            for (int kt = 0; kt < 8; ++kt) S[kt] = MFMA16(kf[kt], vf, S[kt] * gl[kt]);
            { GAS bf16* op = (GAS bf16*)(YCAT + ((size_t)b * SEQ + (size_t)n * 32 + r) * (3 * BW) + ocol + 16 * wave + 4 * kg);
              v2u w; w.x = cvtpk(o0[0], o0[1]); w.y = cvtpk(o0[2], o0[3]); *(GAS v2u*)op = w;
              w.x = cvtpk(o1[0], o1[1]); w.y = cvtpk(o1[2], o1[3]); *(GAS v2u*)(op + (size_t)16 * (3 * BW)) = w; }
            asm volatile("s_waitcnt lgkmcnt(0)" ::: "memory");
            REC_BAR();
        }
    }
    __syncthreads();
#undef REC_BAR
}

__device__ __forceinline__ void post_rows(const Args& args, int l, const bf16* H, bf16* YCAT, int gw, int NGW, int lane) {
    const f32x4 nwg = *(const f32x4*)(args.in[I_GNW] + l * 256 + 4 * lane);
    for (int t0 = gw; t0 < M * 4; t0 += 4 * NGW) {
        v2u ov[4], gv[4]; GAS bf16* yp[4];
#pragma unroll
        for (int j = 0; j < 4; ++j) { const int t = t0 + j * NGW < M * 4 ? t0 + j * NGW : t0; const int row = t >> 2, hh = t & 3;
            yp[j] = (GAS bf16*)(YCAT + (size_t)row * (3 * BW) + BW + hh * 256 + 4 * lane);
            ov[j] = *(const GAS v2u*)yp[j]; gv[j] = *(const GAS v2u*)(H + (size_t)row * NH + HC_GG + hh * 256 + 4 * lane); }
#pragma unroll
        for (int j = 0; j < 4; ++j) {
            const float o0 = bflo(ov[j].x), o1 = bfhi(ov[j].x), o2 = bflo(ov[j].y), o3 = bfhi(ov[j].y);
            const float rstd = rsqrtf(wave_sum(o0 * o0 + o1 * o1 + o2 * o2 + o3 * o3) * (1.0f / 256.0f) + RMS_EPS);
            const float g0 = bflo(gv[j].x), g1 = bfhi(gv[j].x), g2 = bflo(gv[j].y), g3 = bfhi(gv[j].y);
            v2u w; w.x = cvtpk(o0 * rstd * nwg[0] * (g0 * sigm(g0)), o1 * rstd * nwg[1] * (g1 * sigm(g1))); w.y = cvtpk(o2 * rstd * nwg[2] * (g2 * sigm(g2)), o3 * rstd * nwg[3] * (g3 * sigm(g3)));
            if (t0 + j * NGW < M * 4) *(GAS v2u*)yp[j] = w; }
    }
    const f32x4 nwh = *(const f32x4*)(args.in[I_HNW] + l * 128 + 4 * (lane & 31));
    for (int t0 = gw; t0 < M * 4; t0 += 4 * NGW) {
        v2u ov[4], gv[4]; GAS bf16* yp[4];
#pragma unroll
        for (int j = 0; j < 4; ++j) { const int t = t0 + j * NGW < M * 4 ? t0 + j * NGW : t0; const int row = t >> 2, hp = t & 3;
            yp[j] = (GAS bf16*)(YCAT + (size_t)row * (3 * BW) + 2 * BW + hp * 256 + 4 * lane);
            ov[j] = *(const GAS v2u*)yp[j]; gv[j] = *(const GAS v2u*)(H + (size_t)row * NH + HC_HG + hp * 256 + 4 * lane); }
#pragma unroll
        for (int j = 0; j < 4; ++j) {
            const float o0 = bflo(ov[j].x) * sigm(bflo(gv[j].x)), o1 = bfhi(ov[j].x) * sigm(bfhi(gv[j].x)), o2 = bflo(ov[j].y) * sigm(bflo(gv[j].y)), o3 = bfhi(ov[j].y) * sigm(bfhi(gv[j].y));
            const float rstd = rsqrtf(half_sum((o0 * o0 + o1 * o1) + (o2 * o2 + o3 * o3), lane) * (1.0f / 128.0f) + RMS_EPS);
            v2u w; w.x = cvtpk(o0 * rstd * nwh[0], o1 * rstd * nwh[1]); w.y = cvtpk(o2 * rstd * nwh[2], o3 * rstd * nwh[3]);
            if (t0 + j * NGW < M * 4) *(GAS v2u*)yp[j] = w; }
    }
}

__global__ void __launch_bounds__(NWAVES * 64, 2) mega_fwd(Args args) {
    extern __shared__ __attribute__((aligned(16))) unsigned char lds_raw[];
    LAS unsigned char* lds = (LAS unsigned char*)lds_raw;
    volatile LAS unsigned* MISC = (volatile LAS unsigned*)(lds + MISC_OFF);
    const int G = gridDim.x, bid = blockIdx.x;
#define FRESH_IDS() int tid = threadIdx.x; asm volatile("" : "+v"(tid)); const int lane = tid & 63, wave = __builtin_amdgcn_readfirstlane(tid >> 6), gw = bid * NWAVES + wave, NGW = G * NWAVES; (void)lane; (void)gw; (void)NGW
    unsigned* ctl = (unsigned*)(args.ws + WS_CTL);
    for (int u = threadIdx.x; u < (LDS_BYTES - LDSCTL_OFF) / 4; u += NWAVES * 64) ((LAS unsigned*)(lds + LDSCTL_OFF))[u] = 0u;
    __syncthreads();
    const int lo = args.ph_lo, hi = args.ph_hi;
    const bool use_bar = (hi - lo) > 1;
    unsigned* barw = ctl + CW_BAR + args.bar_idx * XCD_BAR_WORDS;
    XcdBarrier bar; bar.bar = barw; bar.x = 0; bar.st = nullptr;
    if (use_bar) bar = xcd_barrier_post(barw, MISC + 8);
#ifndef PHMASK
#define PHMASK 0x3ff
#endif
#define IN(k) (((PHMASK >> ((k) % NPH)) & 1) && lo <= (k) && (k) < hi)
#define SEAM(k) do { if (lo <= (k) && (k) + 1 < hi) xcd_barrier(bar); } while (0)
#ifndef REP_PH
#define REP_PH -1
#endif
#ifndef REP_N
#define REP_N 1
#endif
#define RPT(k) for (int rep_ = 0; rep_ < ((k) == REP_PH ? 1 + REP_N : 1); ++rep_)

#define PTRS() unsigned char* ws = args.ws; asm volatile("" : "+s"(ws)); bf16* WinT = (bf16*)(ws + WS_WIN); bf16* WgluT = (bf16*)(ws + WS_WGLU); bf16* WupT = (bf16*)(ws + WS_WUP); bf16* WoutT = (bf16*)(ws + WS_WOUT); bf16* W1T = (bf16*)(ws + WS_W1); bf16* W2T = (bf16*)(ws + WS_W2); bf16* XB = (bf16*)(ws + WS_XB); bf16* Y = (bf16*)(ws + WS_Y); bf16* H = (bf16*)(ws + WS_H); bf16* HID = (bf16*)(ws + WS_H); bf16* Z = (bf16*)(ws + WS_Z); bf16* YCAT = (bf16*)(ws + WS_YCAT); bf16* MERGED = (bf16*)(ws + WS_MERGED); bf16* UU = (bf16*)(ws + WS_U); bf16* S5W = (bf16*)(ws + WS_S5W); bf16* S5TQ = (bf16*)(ws + WS_S5TQ); float* S5C = (float*)(ws + WS_S5C); bf16* WglowT = (bf16*)(ws + WS_WGLOW); float* GLOW = (float*)(ws + WS_GLOW); unsigned char* BND = ws + WS_BND; bf16* VT = (bf16*)(ws + WS_VT); bf16* Y2 = (bf16*)(ws + WS_Y2); float* ST1 = (float*)(ws + WS_ST); float* ST2 = ST1 + 2 * M; float* ST0 = (float*)(ws + WS_ID); (void)WinT; (void)WgluT; (void)WupT; (void)WoutT; (void)W1T; (void)W2T; (void)XB; (void)Y; (void)H; (void)HID; (void)Z; (void)YCAT; (void)MERGED; (void)UU; (void)S5W; (void)S5TQ; (void)S5C; (void)WglowT; (void)GLOW; (void)BND; (void)VT; (void)Y2; (void)ST1; (void)ST2; (void)ST0;

    for (int l = 0; l < DEPTH; ++l) {
        const int P = l * NPH;
        RPT(0) if (IN(P + 0)) {
            PTRS(); FRESH_IDS();
            if (l > 0) ln_phase(Y2, args.in[I_LN2G] + (size_t)(l - 1) * D, args.in[I_LN2B] + (size_t)(l - 1) * D, nullptr, XB, ST2, gw, NGW, lane);
            if (l == 0) for (int lg = bid; lg < DEPTH * 64; lg += G) s5_build(args, lg >> 6, lg & 63, S5W + (size_t)lg * 128 * 256, S5TQ + (size_t)lg * 256 * 384, S5C + (size_t)lg * 256, lds, tid);
            __syncthreads();
            LAS float* scr = (LAS float*)(lds + wave * 16384);
            const float* w_in = args.in[I_WIN] + (size_t)l * D * IN_TOTAL;
            const float* w_glu = args.in[I_WGLU] + (size_t)l * BW * BW;
            const float* w_up = args.in[I_WUP] + (size_t)l * 3 * BW * D;
            const float* w_out = args.in[I_WOUT] + (size_t)l * D * D;
            const float* w1 = args.in[I_W1] + (size_t)l * D * FF;
            const float* w2 = args.in[I_W2] + (size_t)l * FF * D;
            constexpr int I_A = (D / 64) * (3072 / 32), I_B = (D / 64) * ((NH - 3072) / 32), I_G = (BW / 64) * (BW / 32), I_U = (BW / 64) * (D / 32), I_O = (D / 64) * (D / 32), I_1 = (D / 64) * (FF / 32), I_2 = (FF / 64) * (D / 32), I_L = D / 64;
            constexpr int NITEMS = I_A + I_B + I_G + 3 * I_U + I_O + I_1 + I_2 + I_L;
            for (int it = gw; it < NITEMS; it += NGW) {
                int r = it;
                if (r < I_A) { cvt_item(w_in, IN_TOTAL, 0, WinT, D, 0, 0, 3072 / 32, r, scr, lane); continue; } r -= I_A;
                if (r < I_B) { cvt_item(w_in, IN_TOTAL, 3072 + 16, WinT, D, 3072, 0, (NH - 3072) / 32, r, scr, lane); continue; } r -= I_B;
                if (r < I_G) { cvt_item(w_glu, BW, 0, WgluT, BW, 0, 0, BW / 32, r, scr, lane); continue; } r -= I_G;
                if (r < 3 * I_U) { const int b = r / I_U; cvt_item(w_up + (size_t)b * BW * D, D, 0, WupT, 3 * BW, 0, b * BW, D / 32, r - b * I_U, scr, lane); continue; } r -= 3 * I_U;
                if (r < I_O) { cvt_item(w_out, D, 0, WoutT, D, 0, 0, D / 32, r, scr, lane); continue; } r -= I_O;
                if (r < I_1) { cvt_item(w1, FF, 0, W1T, D, 0, 0, FF / 32, r, scr, lane); continue; } r -= I_1;
                if (r < I_2) { cvt_item(w2, D, 0, W2T, FF, 0, 0, D / 32, r, scr, lane); continue; } r -= I_2;
                cvt_item(w_in, IN_TOTAL, GLOW_COL, WglowT, D, 0, 0, 1, r, scr, lane);
            }
            if (l == 0) {
                for (int i = bid * 512 + tid; i < 2 * M + 2 * D + DEPTH * 4 * D; i += G * 512) {
                    float v;
                    if (i < 2 * M) v = (float)(i & 1); else if (i < 2 * M + D) v = 1.0f; else if (i < 2 * M + 2 * D) v = 0.0f;
                    else { const int e = i - 2 * M - 2 * D, ll = e / (4 * D), w = (e / D) & 3, c = e % D; const float a0 = args.in[I_LN1G][ll * D + c], a1 = args.in[I_LN1B][ll * D + c], a2 = args.in[I_LN2G][ll * D + c], a3 = args.in[I_LN2B][ll * D + c];
                           v = w == 0 ? a0 : w == 1 ? a1 : w == 2 ? a2 : a3; }
                    ST0[i] = v; }
                const f32x4* xs = (const f32x4*)args.in[I_X]; unsigned long long* xd = (unsigned long long*)XB;
                unsigned long long* xh = (unsigned long long*)Y2;
                for (size_t i = (size_t)bid * 512 + tid; i < (size_t)M * D / 4; i += (size_t)G * 512) { const f32x4 v = xs[i]; xd[i] = (unsigned long long)pk2(v[0], v[1]) | ((unsigned long long)pk2(v[2], v[3]) << 32); xh[i] = (unsigned long long)cvtpk_h(v[0], v[1]) | ((unsigned long long)cvtpk_h(v[2], v[3]) << 32); }
            }
        }
        SEAM(P + 0);
        RPT(1) if (IN(P + 1)) {
            PTRS();
            { pg8::Gemm g{XB, WinT, M, NH, D}; pg8::StaticOrder S; S.init(M, NH, G, bid);
              pg8::EpiH E{H, NH, UU};
              pg8::gemm_phase<pg8::EpiH, pg8::StaticOrder, true, true>(lds, g, S, E); }
            FRESH_IDS();
            if (wave < 4) for (int gq = bid; gq < M / 64; gq += G) glow_tile(XB, WglowT, GLOW, gq * 64 + 16 * wave, lane);
        }
        SEAM(P + 1);
        RPT(2) if (IN(P + 2)) {
            PTRS(); FRESH_IDS();
            if (bid < 48 * 64) prep_dma(bid, 0, H, GLOW, lds, tid);
            { int p = 0; for (int u = bid; u < 48 * 64; u += G, p ^= 1) prep_unit(args, l, u, u + G, p, H, GLOW, BND, lds, tid); }
            __syncthreads();
        }
        SEAM(P + 2);
        RPT(3) if (IN(P + 3)) {
            PTRS(); FRESH_IDS();
            const int nrec = G >= 256 ? 128 : G / 2;
#ifndef REP_REC
#define REP_REC 0
#endif
            if (bid < nrec) { for (int rr_ = 0; rr_ <= REP_REC; ++rr_) for (int v = bid; v < 128; v += nrec) {
                    const int x = v & 7, sl = v >> 3; const int u = sl < 8 ? (2 * x + (sl >> 2)) * 4 + (sl & 3) : 64 + (4 * x + ((sl - 8) >> 1)) * 2 + ((sl - 8) & 1);
                    rec_unit(u, BND, H, YCAT, lds, tid); } }
#ifndef REP_S5
#define REP_S5 0
#endif
            else { for (int rs_ = 0; rs_ <= REP_S5; ++rs_) for (int u = bid - nrec; u < 256; u += G - nrec) { const int b = u >> 6, g = u & 63;
                    s5_unit(UU + (size_t)(b * 64 + g) * SEQ * 16, S5W + (size_t)(l * 64 + g) * 128 * 256, S5TQ + (size_t)(l * 64 + g) * 256 * 384, S5C + (size_t)(l * 64 + g) * 256, args.in[I_S5D] + l * BW + g * 16, Z + (size_t)b * SEQ * BW + g * 16, lds, tid); } }
        }
        SEAM(P + 3);
        RPT(4) if (IN(P + 4)) {
            PTRS();
            { pg8::Gemm g{Z, WgluT, M, BW, BW}; pg8::StaticOrder S; S.init(M, BW, G, bid, 2);
              pg8::EpiGlu E{YCAT, 3 * BW, Z, BW, args.in[I_BGLU] + (size_t)l * BW};
              pg8::gemm_phase<pg8::EpiGlu, pg8::StaticOrder, true, true>(lds, g, S, E); }
            FRESH_IDS();
            post_rows(args, l, H, YCAT, gw, NGW, lane);
        }
        SEAM(P + 4);
        RPT(5) if (IN(P + 5)) {
            PTRS();
            pg8::Gemm g{YCAT, WupT, M, D, 3 * BW}; pg8::StaticOrder S; S.init(M, D, G, bid, 2);
            pg8::EpiMergeK E{MERGED, D, H + HC_MG, NH, D};
            pg8::gemm_phase<pg8::EpiMergeK, pg8::StaticOrder, true, true>(lds, g, S, E);
        }
        SEAM(P + 5);
        RPT(6) if (IN(P + 6)) {
            PTRS();
            pg8::Gemm g{MERGED, WoutT, M, D, D}; pg8::StaticOrder S; S.init(M, D, G, bid, 2);
            pg8::EpiRes E{Y, Y2, l == 0 ? ST0 : ST2, ST0 + 2 * M + (l == 0 ? 0 : 2 * D + (l - 1) * 4 * D + 2 * D)};
            pg8::gemm_phase<pg8::EpiRes, pg8::StaticOrder, true, true>(lds, g, S, E);
        }
        SEAM(P + 6);
        RPT(7) if (IN(P + 7)) { PTRS(); FRESH_IDS(); ln_phase(Y, args.in[I_LN1G] + (size_t)l * D, args.in[I_LN1B] + (size_t)l * D, nullptr, XB, ST1, gw, NGW, lane); }
        SEAM(P + 7);
        RPT(8) if (IN(P + 8)) {
            PTRS();
            pg8::Gemm g{XB, W1T, M, FF, D}; pg8::StaticOrder S; S.init(M, FF, G, bid);
            pg8::EpiRelu2 E{HID, FF};
            pg8::gemm_phase<pg8::EpiRelu2, pg8::StaticOrder, true, true>(lds, g, S, E);
        }
        SEAM(P + 8);
        RPT(9) if (IN(P + 9)) {
            PTRS();
            pg8::Gemm g{HID, W2T, M, D, FF}; pg8::StaticOrder S; S.init(M, D, G, bid, 2);
            pg8::EpiRes E{Y2, Y, ST1, ST0 + 2 * M + 2 * D + l * 4 * D};
            pg8::gemm_phase<pg8::EpiRes, pg8::StaticOrder, true, true>(lds, g, S, E);
        }
        SEAM(P + 9);
    }
    if (IN(DEPTH * NPH)) { PTRS(); FRESH_IDS(); ln_phase(Y2, args.in[I_LN2G] + (size_t)(DEPTH - 1) * D, args.in[I_LN2B] + (size_t)(DEPTH - 1) * D, args.out, XB, ST2, gw, NGW, lane); }
#undef IN
#undef SEAM
}

#ifndef N_SPLIT
#define N_SPLIT 1
#endif
extern "C" void kernel_launch(void* const* d_in, const int* in_sizes, int n_in, void* d_out, int out_size, void* d_ws, size_t ws_size, hipStream_t stream) {
    static int grid = 0;
    if (grid == 0) {
        if (n_in != 25 || out_size != M * D || ws_size < WS_END) { fprintf(stderr, "kernel_launch: unexpected shapes (n_in %d out %d ws %zu need %zu)\n", n_in, out_size, ws_size, (size_t)WS_END); grid = -1; return; }
        int dev = 0, cus = 0;
        if (hipGetDevice(&dev) != hipSuccess || hipDeviceGetAttribute(&cus, hipDeviceAttributeMultiprocessorCount, dev) != hipSuccess) { grid = -1; return; }
        if (hipFuncSetAttribute((const void*)mega_fwd, hipFuncAttributeMaxDynamicSharedMemorySize, LDS_BYTES) != hipSuccess) { fprintf(stderr, "kernel_launch: hipFuncSetAttribute failed\n"); grid = -1; return; }
        int per_cu = 0;
        (void)hipOccupancyMaxActiveBlocksPerMultiprocessor(&per_cu, (const void*)mega_fwd, NWAVES * 64, LDS_BYTES);
        (void)hipGetLastError();
        grid = cus;
    }
    if (grid < 0) return;
    (void)hipMemsetAsync((char*)d_ws + WS_CTL, 0, CTL_ZERO_BYTES, stream);
    Args a{};
    for (int i = 0; i < 25; ++i) a.in[i] = (const float*)d_in[i];
    a.out = (float*)d_out; a.ws = (unsigned char*)d_ws;
#if N_SPLIT == 1
    a.ph_lo = 0; a.ph_hi = DEPTH * NPH + 1; a.bar_idx = 0;
    hipLaunchKernelGGL(mega_fwd, dim3(grid), dim3(NWAVES * 64), LDS_BYTES, stream, a);
#else
    for (int p = 0; p < DEPTH * NPH + 1; ++p) { a.ph_lo = p; a.ph_hi = p + 1; a.bar_idx = 0; hipLaunchKernelGGL(mega_fwd, dim3(grid), dim3(NWAVES * 64), LDS_BYTES, stream, a);
    }
#endif
}
```

```cpp
#include <hip/hip_runtime.h>
#include <cstdio>
#include <cstdint>
namespace pg8 {
#define PG8_LAS __attribute__((address_space(3)))
typedef unsigned short bf16_t;
typedef short bf16x8 __attribute__((ext_vector_type(8)));
typedef float f32x4 __attribute__((ext_vector_type(4)));
typedef unsigned u32x4 __attribute__((ext_vector_type(4)));
constexpr int BM = 256, BK = 64, HALF = 128, HTB = HALF * BK * 2  , STAGE_BYTES = 8 * HTB, NXCD = 8, WGM = 8;

__host__ __device__ __forceinline__ int lds_byte(int r, int c) { const int st = (r >> 4) * 2 + (c >> 5), rr = r & 15, cc = c & 31, ob = rr * 64 + cc * 2; return st * 1024 + (ob ^ (((ob >> 9) & 1) << 5)); }
__host__ __device__ __forceinline__ void stage_rc(int b, int& R, int& C) { const int st = b / 1024, sb = b % 1024, swz = sb ^ (((sb >> 9) & 1) << 5); R = (st >> 1) * 16 + swz / 64; C = (st & 1) * 32 + (swz % 64) / 2; }
__host__ __device__ __forceinline__ int perm32(int rho) { const int n = rho >> 4, i = rho & 15; return 8 * (i >> 2) + 4 * n + (i & 3); }

struct Unit { int pm, pn; };
struct Gemm { const bf16_t* A; const bf16_t* Bt; int M, N, K; };

struct StaticOrder {
    int nM, nN, nwg, G, c, wgm;
    __host__ __device__ void init(int M, int N, int G_, int c_, int wgm_ = WGM) { nM = M / BM; nN = N / BM; nwg = nM * nN; G = G_; c = c_; wgm = wgm_; }
    __host__ __device__ bool next(int i, Unit& u) const {
        const long L = (long)i * G + c; if (L >= nwg) return false;
        int wgid = (int)L; { const int q = nwg / NXCD, r = nwg % NXCD, xcd = wgid % NXCD, off = wgid / NXCD; wgid = (xcd < r ? xcd * (q + 1) : r * (q + 1) + (xcd - r) * q) + off; }
        const int nig = wgm * nN, gid = wgid / nig, fm = gid * wgm, gsz = (nM - fm) < wgm ? (nM - fm) : wgm;
        u.pm = fm + ((wgid % nig) % gsz); u.pn = (wgid % nig) / gsz; return true;
    }
    __device__ __forceinline__ void a_ready(const Unit&) const {}
    __device__ __forceinline__ void done(const Unit&) const {}
};

__device__ __forceinline__ unsigned cvt_pk_bf16(float lo, float hi) { unsigned r; asm volatile("v_cvt_pk_bf16_f32 %0, %1, %2" : "=v"(r) : "v"(lo), "v"(hi)); return r; }
typedef float f32x2 __attribute__((ext_vector_type(2)));

typedef unsigned u32x2 __attribute__((ext_vector_type(2)));
__device__ __forceinline__ float bf_lo(unsigned w) { return __uint_as_float(w << 16); }
__device__ __forceinline__ float bf_hi(unsigned w) { return __uint_as_float(w & 0xffff0000u); }
__device__ __forceinline__ float sigmoidf_(float x) { return __builtin_amdgcn_rcpf(1.0f + __expf(-x)); }

typedef _Float16 f16x2_ __attribute__((ext_vector_type(2)));
__device__ __forceinline__ unsigned cvt_pk_f16(float lo, float hi) { const f32x2 v = {lo, hi}; const f16x2_ h = __builtin_convertvector(v, f16x2_); return __builtin_bit_cast(unsigned, h); }
__device__ __forceinline__ f32x2 unpk_f16(unsigned w) { const f16x2_ h = __builtin_bit_cast(f16x2_, w); return __builtin_convertvector(h, f32x2); }
struct EpiBf16Plain {
    static constexpr bool PERM = true, AFTER_DRAIN = false;
    bf16_t* O; int ldc;
    __device__ __forceinline__ void operator()(const f32x4 (&acc)[2][2][4][2], const Unit& u, int wr, int wc, int fr, int fq) const {
        const int row0 = u.pm * BM + wr * 64 + fr, col0 = u.pn * BM + wc * 32 + 8 * fq;
#pragma unroll
        for (int ai = 0; ai < 2; ++ai)
#pragma unroll
            for (int m = 0; m < 4; ++m) { bf16_t* rowp = O + (size_t)(row0 + ai * HALF + m * 16) * ldc + col0;
#pragma unroll
                for (int bj = 0; bj < 2; ++bj) { const f32x4 v0 = acc[ai][bj][m][0], v1 = acc[ai][bj][m][1];
                    u32x4 w; w.x = cvt_pk_bf16(v0[0], v0[1]); w.y = cvt_pk_bf16(v0[2], v0[3]); w.z = cvt_pk_bf16(v1[0], v1[1]); w.w = cvt_pk_bf16(v1[2], v1[3]);
                    *(u32x4*)(rowp + bj * HALF) = w; } }
    }
};
struct EpiH {
    static constexpr bool PERM = true, AFTER_DRAIN = false;
    bf16_t* O; int ldc; bf16_t* U;
    __device__ __forceinline__ void operator()(const f32x4 (&acc)[2][2][4][2], const Unit& u, int wr, int wc, int fr, int fq) const {
        const int row0 = u.pm * BM + wr * 64 + fr, col0 = u.pn * BM + wc * 32 + 8 * fq;
        const bool isu = u.pn < 4, isg = u.pn >= 32;
#pragma unroll
        for (int ai = 0; ai < 2; ++ai)
#pragma unroll
            for (int m = 0; m < 4; ++m) { const int row = row0 + ai * HALF + m * 16;
#pragma unroll
                for (int bj = 0; bj < 2; ++bj) { f32x4 v0 = acc[ai][bj][m][0], v1 = acc[ai][bj][m][1];
                    if (isg) {
#pragma unroll
                        for (int j = 0; j < 4; ++j) { v0[j] = 1.0f + __expf(-fminf(fmaxf(v0[j], -30.f), 30.f)); v1[j] = 1.0f + __expf(-fminf(fmaxf(v1[j], -30.f), 30.f)); } }
                    u32x4 w; w.x = cvt_pk_bf16(v0[0], v0[1]); w.y = cvt_pk_bf16(v0[2], v0[3]); w.z = cvt_pk_bf16(v1[0], v1[1]); w.w = cvt_pk_bf16(v1[2], v1[3]);
                    const int col = col0 + bj * HALF;
                    bf16_t* dst = isu ? U + ((size_t)((row >> 12) * 64 + (col >> 4)) * 4096 + (row & 4095)) * 16 + (col & 8) : O + (size_t)row * ldc + col;
                    *(u32x4*)dst = w; } }
    }
};
struct EpiRelu2 {
    static constexpr bool PERM = true, AFTER_DRAIN = false;
    bf16_t* O; int ldc;
    __device__ __forceinline__ void operator()(const f32x4 (&acc)[2][2][4][2], const Unit& u, int wr, int wc, int fr, int fq) const {
        const int row0 = u.pm * BM + wr * 64 + fr, col0 = u.pn * BM + wc * 32 + 8 * fq;
#pragma unroll
        for (int ai = 0; ai < 2; ++ai)
#pragma unroll
            for (int m = 0; m < 4; ++m) { bf16_t* rowp = O + (size_t)(row0 + ai * HALF + m * 16) * ldc + col0;
#pragma unroll
                for (int bj = 0; bj < 2; ++bj) { f32x4 v0 = acc[ai][bj][m][0], v1 = acc[ai][bj][m][1];
#pragma unroll
                    for (int j = 0; j < 4; ++j) { const float a = fmaxf(v0[j], 0.f), b = fmaxf(v1[j], 0.f); v0[j] = a * a; v1[j] = b * b; }
                    u32x4 w; w.x = cvt_pk_bf16(v0[0], v0[1]); w.y = cvt_pk_bf16(v0[2], v0[3]); w.z = cvt_pk_bf16(v1[0], v1[1]); w.w = cvt_pk_bf16(v1[2], v1[3]);
                    *(u32x4*)(rowp + bj * HALF) = w; } }
    }
};
struct EpiGlu {
    static constexpr bool PERM = true, AFTER_DRAIN = false;
    bf16_t* O; int ldc; const bf16_t* Z; int ldz; const float* bias;
    __device__ __forceinline__ void operator()(const f32x4 (&acc)[2][2][4][2], const Unit& u, int wr, int wc, int fr, int fq) const {
        const int row0 = u.pm * BM + wr * 64 + fr, col0 = u.pn * BM + wc * 32 + 8 * fq;
        f32x4 bv[2][2];
#pragma unroll
        for (int bj = 0; bj < 2; ++bj)
#pragma unroll
            for (int n = 0; n < 2; ++n) bv[bj][n] = *(const f32x4*)(bias + col0 + bj * HALF + 4 * n);
#pragma unroll
        for (int ai = 0; ai < 2; ++ai)
#pragma unroll
            for (int m = 0; m < 4; ++m) { const size_t r = (size_t)(row0 + ai * HALF + m * 16);
#pragma unroll
                for (int bj = 0; bj < 2; ++bj) { f32x4 v0 = acc[ai][bj][m][0] + bv[bj][0], v1 = acc[ai][bj][m][1] + bv[bj][1];
                    const u32x4 zz = *(const u32x4*)(Z + r * ldz + col0 + bj * HALF);
                    v0[0] = bf_lo(zz.x) * sigmoidf_(v0[0]); v0[1] = bf_hi(zz.x) * sigmoidf_(v0[1]); v0[2] = bf_lo(zz.y) * sigmoidf_(v0[2]); v0[3] = bf_hi(zz.y) * sigmoidf_(v0[3]);
                    v1[0] = bf_lo(zz.z) * sigmoidf_(v1[0]); v1[1] = bf_hi(zz.z) * sigmoidf_(v1[1]); v1[2] = bf_lo(zz.w) * sigmoidf_(v1[2]); v1[3] = bf_hi(zz.w) * sigmoidf_(v1[3]);
                    u32x4 w; w.x = cvt_pk_bf16(v0[0], v0[1]); w.y = cvt_pk_bf16(v0[2], v0[3]); w.z = cvt_pk_bf16(v1[0], v1[1]); w.w = cvt_pk_bf16(v1[2], v1[3]);
                    *(u32x4*)(O + r * ldc + col0 + bj * HALF) = w; } }
    }
};
struct EpiRes {
    static constexpr bool PERM = true, AFTER_DRAIN = false, HAS_INIT = true;
    static constexpr int ldc = 2048; static constexpr float alpha = 1.681792830507429f;
    bf16_t* Y; const bf16_t* X;
    const float* ST; const float* GB;
    __device__ __forceinline__ void init(f32x4 (&acc)[2][2][4][2], const Unit& u, int wr, int wc, int fr_, int fq) const {
        int fr = fr_; asm volatile("" : "+v"(fr));
        const int row0 = u.pm * BM + wr * 64 + fr, col0 = u.pn * BM + wc * 32 + 8 * fq;
#pragma unroll
        for (int ai = 0; ai < 2; ++ai)
#pragma unroll
            for (int m = 0; m < 4; ++m) { const bf16_t* rp = X + (size_t)(row0 + ai * HALF + m * 16) * ldc + col0;
#pragma unroll
                for (int bj = 0; bj < 2; ++bj) { const u32x4 w = *(const u32x4*)(rp + bj * HALF);
                    const f32x2 a = unpk_f16(w.x), b = unpk_f16(w.y), c = unpk_f16(w.z), d = unpk_f16(w.w);
                    acc[ai][bj][m][0] = (f32x4){a.x, a.y, b.x, b.y}; acc[ai][bj][m][1] = (f32x4){c.x, c.y, d.x, d.y}; } }
        f32x2 st[2][4];
#pragma unroll
        for (int ai = 0; ai < 2; ++ai)
#pragma unroll
            for (int m = 0; m < 4; ++m) st[ai][m] = *(const f32x2*)(ST + 2 * (size_t)(row0 + ai * HALF + m * 16));
#pragma unroll
        for (int bj = 0; bj < 2; ++bj)
#pragma unroll
            for (int n = 0; n < 2; ++n) { const int c = col0 + bj * HALF + n * 4;
                const f32x4 gv = *(const f32x4*)(GB + c) * alpha, bv = *(const f32x4*)(GB + ldc + c) * alpha;
#pragma unroll
                for (int ai = 0; ai < 2; ++ai)
#pragma unroll
                    for (int m = 0; m < 4; ++m) acc[ai][bj][m][n] = (acc[ai][bj][m][n] - st[ai][m].x) * st[ai][m].y * gv + bv; }
    }
    __device__ __forceinline__ void operator()(const f32x4 (&acc)[2][2][4][2], const Unit& u, int wr, int wc, int fr, int fq) const {
        const int row0 = u.pm * BM + wr * 64 + fr, col0 = u.pn * BM + wc * 32 + 8 * fq;
#pragma unroll
        for (int ai = 0; ai < 2; ++ai)
#pragma unroll
            for (int m = 0; m < 4; ++m) { bf16_t* rowp = Y + (size_t)(row0 + ai * HALF + m * 16) * ldc + col0;
#pragma unroll
                for (int bj = 0; bj < 2; ++bj) { const f32x4 v0 = acc[ai][bj][m][0], v1 = acc[ai][bj][m][1];
                    u32x4 w; w.x = cvt_pk_f16(v0[0], v0[1]); w.y = cvt_pk_f16(v0[2], v0[3]); w.z = cvt_pk_f16(v1[0], v1[1]); w.w = cvt_pk_f16(v1[2], v1[3]);
                    *(u32x4*)(rowp + bj * HALF) = w; } }
    }
};
template <int MODE> struct EpiMerge {
    static constexpr bool PERM = false, AFTER_DRAIN = false;
    float* T; bf16_t* O; int ldc; const bf16_t* G; int ldg;
    __device__ __forceinline__ void operator()(const f32x4 (&acc)[2][2][4][2], const Unit& u, int wr, int wc, int fr, int fq) const {
        const int row0 = u.pm * BM + wr * 64 + fr, col0 = u.pn * BM + wc * 32 + 4 * fq;
#pragma unroll
        for (int ai = 0; ai < 2; ++ai)
#pragma unroll
            for (int m = 0; m < 4; ++m) { const size_t r = (size_t)(row0 + ai * HALF + m * 16);
#pragma unroll
                for (int bj = 0; bj < 2; ++bj)
#pragma unroll
                    for (int n = 0; n < 2; ++n) { const int c = col0 + bj * HALF + n * 16;
                        const u32x2 gg = *(const u32x2*)(G + r * ldg + c);
                        f32x4 gv; gv[0] = sigmoidf_(bf_lo(gg.x)); gv[1] = sigmoidf_(bf_hi(gg.x)); gv[2] = sigmoidf_(bf_lo(gg.y)); gv[3] = sigmoidf_(bf_hi(gg.y));
                        f32x4 v = gv * acc[ai][bj][m][n];
                        if (MODE != 0) v = v + *(const f32x4*)(T + r * ldc + c);
                        if (MODE != 2) *(f32x4*)(T + r * ldc + c) = v;
                        else { u32x2 w; w.x = cvt_pk_bf16(v[0], v[1]); w.y = cvt_pk_bf16(v[2], v[3]); *(u32x2*)(O + r * ldc + c) = w; } } }
    }
};

struct EpiMergeK {
    static constexpr bool PERM = true, AFTER_DRAIN = false, HAS_HOOK = true;
    bf16_t* O; int ldc; const bf16_t* G; int ldg; int gstride;
    __device__ __forceinline__ void hook(f32x4 (&acc)[2][2][4][2], const Unit& u, int seam, int wr, int wc, int fr_, int fq) const {
        int fr = fr_; asm volatile("" : "+v"(fr));
        const int row0 = u.pm * BM + wr * 64 + fr, col0 = u.pn * BM + wc * 32 + 8 * fq;
        const bf16_t* gd = G + (size_t)(seam - 1) * gstride; const bf16_t* gn = gd + gstride;
#pragma unroll
        for (int ai = 0; ai < 2; ++ai) {
            u32x4 a[4][2], b[4][2];
#pragma unroll
            for (int m = 0; m < 4; ++m) { const size_t r = (size_t)(row0 + ai * HALF + m * 16) * ldg + col0;
#pragma unroll
                for (int bj = 0; bj < 2; ++bj) { a[m][bj] = *(const u32x4*)(gn + r + bj * HALF); b[m][bj] = *(const u32x4*)(gd + r + bj * HALF); } }
#pragma unroll
            for (int m = 0; m < 4; ++m)
#pragma unroll
                for (int bj = 0; bj < 2; ++bj) { const u32x4 x = a[m][bj], y = b[m][bj];
                    f32x4 q0, q1;
                    q0[0] = bf_lo(x.x) * __builtin_amdgcn_rcpf(bf_lo(y.x)); q0[1] = bf_hi(x.x) * __builtin_amdgcn_rcpf(bf_hi(y.x)); q0[2] = bf_lo(x.y) * __builtin_amdgcn_rcpf(bf_lo(y.y)); q0[3] = bf_hi(x.y) * __builtin_amdgcn_rcpf(bf_hi(y.y));
                    q1[0] = bf_lo(x.z) * __builtin_amdgcn_rcpf(bf_lo(y.z)); q1[1] = bf_hi(x.z) * __builtin_amdgcn_rcpf(bf_hi(y.z)); q1[2] = bf_lo(x.w) * __builtin_amdgcn_rcpf(bf_lo(y.w)); q1[3] = bf_hi(x.w) * __builtin_amdgcn_rcpf(bf_hi(y.w));
                    acc[ai][bj][m][0] = acc[ai][bj][m][0] * q0; acc[ai][bj][m][1] = acc[ai][bj][m][1] * q1; }
            asm volatile("" ::: "memory"); }
    }
    __device__ __forceinline__ void operator()(const f32x4 (&acc)[2][2][4][2], const Unit& u, int wr, int wc, int fr, int fq) const {
        const int row0 = u.pm * BM + wr * 64 + fr, col0 = u.pn * BM + wc * 32 + 8 * fq;
        const bf16_t* g2 = G + (size_t)2 * gstride;
#pragma unroll
        for (int ai = 0; ai < 2; ++ai)
#pragma unroll
            for (int m = 0; m < 4; ++m) { const size_t r = (size_t)(row0 + ai * HALF + m * 16);
#pragma unroll
                for (int bj = 0; bj < 2; ++bj) { const u32x4 a = *(const u32x4*)(g2 + r * ldg + col0 + bj * HALF);
                    const f32x4 v0 = acc[ai][bj][m][0], v1 = acc[ai][bj][m][1];
#define RG_(x) __builtin_amdgcn_rcpf(x)
                    u32x4 w; w.x = cvt_pk_bf16(v0[0] * RG_(bf_lo(a.x)), v0[1] * RG_(bf_hi(a.x))); w.y = cvt_pk_bf16(v0[2] * RG_(bf_lo(a.y)), v0[3] * RG_(bf_hi(a.y)));
                    w.z = cvt_pk_bf16(v1[0] * RG_(bf_lo(a.z)), v1[1] * RG_(bf_hi(a.z))); w.w = cvt_pk_bf16(v1[2] * RG_(bf_lo(a.w)), v1[3] * RG_(bf_hi(a.w)));
#undef RG_
                    *(u32x4*)(O + r * ldc + col0 + bj * HALF) = w; } }
    }
};
template <class E, class = void> struct epi_has_init { static constexpr bool value = false; };
template <class E> struct epi_has_init<E, decltype((void)E::HAS_INIT)> { static constexpr bool value = E::HAS_INIT; };
template <class E, class = void> struct epi_has_hook { static constexpr bool value = false; };
template <class E> struct epi_has_hook<E, decltype((void)E::HAS_HOOK)> { static constexpr bool value = E::HAS_HOOK; };

template <class Epi, class Sched, bool ALIGN_EPI = false, bool SP2 = false>
__device__ __forceinline__ void gemm_phase_ld(PG8_LAS unsigned char* lds, const Gemm g, const int lda, const int ldb, const Sched& S, const Epi& E) {
    int tid_ = threadIdx.x; asm volatile("" : "+v"(tid_));
    const int tid = tid_, wid = __builtin_amdgcn_readfirstlane(tid >> 6), lane = tid & 63, wr = wid >> 2, wc = wid & 3, fr = lane & 15, fq = lane >> 4;
    const int K = g.K, nt = K / BK;
    unsigned voffA[2], voffB[2];
#pragma unroll
    for (int i = 0; i < 2; ++i) { int R, C; stage_rc(tid * 16 + i * 8192, R, C); const int Rb = Epi::PERM ? ((R & ~31) + perm32(R & 31)) : R;
        voffA[i] = (unsigned)(R * lda + C) * 2u; voffB[i] = (unsigned)(Rb * ldb + C) * 2u; }
    const size_t kstep = (size_t)(BK * 2);
    const size_t hstepA = (size_t)HALF * lda * 2, hstepB = (size_t)HALF * ldb * 2;
    const size_t tstepA = 2 * hstepA, tstepB = 2 * hstepB;
    const unsigned ldsw = (unsigned)wid * 1024u;
    const int aoff = lds_byte(wr * 64 + fr, fq * 8), boff = lds_byte(wc * 32 + fr, fq * 8);
#define PG8_SA(b, h) (((b) * 2 + (h)) * HTB)
#define PG8_SB(b, h) ((4 + (b) * 2 + (h)) * HTB)
#define PG8_STAGE(bufoff, gbase, voff) do { _Pragma("unroll") for (int _i = 0; _i < 2; ++_i) \
        __builtin_amdgcn_global_load_lds((const unsigned*)((const char*)(gbase) + (voff)[_i]), (PG8_LAS unsigned*)(lds + (bufoff) + ldsw + _i * 8192), 16, 0, 0); } while (0)
#define PG8_LDA(dst, b, h) do { _Pragma("unroll") for (int m = 0; m < 4; ++m) _Pragma("unroll") for (int k = 0; k < 2; ++k) dst[m][k] = *(const PG8_LAS bf16x8*)(lds + PG8_SA(b, h) + aoff + m * 2048 + k * 1024); } while (0)
#define PG8_LDB(dst, b, h) do { _Pragma("unroll") for (int n = 0; n < 2; ++n) _Pragma("unroll") for (int k = 0; k < 2; ++k) dst[n][k] = *(const PG8_LAS bf16x8*)(lds + PG8_SB(b, h) + boff + n * 2048 + k * 1024); } while (0)
#define PG8_MMA(ai, bj, At, Bt) do { __builtin_amdgcn_s_setprio(1); _Pragma("unroll") for (int m = 0; m < 4; ++m) _Pragma("unroll") for (int n = 0; n < 2; ++n) _Pragma("unroll") for (int k = 0; k < 2; ++k) \
        acc[ai][bj][m][n] = __builtin_amdgcn_mfma_f32_16x16x32_bf16(Bt[n][k], At[m][k], acc[ai][bj][m][n], 0, 0, 0); __builtin_amdgcn_s_setprio(0); } while (0)
#define PG8_WAIT_V(n) asm volatile("s_waitcnt vmcnt(" #n ")" ::: "memory")
#define PG8_WAIT_L(n) asm volatile("s_waitcnt lgkmcnt(" #n ")" ::: "memory")
#define PG8_BAR __builtin_amdgcn_s_barrier()
#define PG8_SCHED __builtin_amdgcn_sched_barrier(0)
    Unit cur, nxt; int ui = 0;
    if (!S.next(0, cur)) return;
    f32x4 acc[2][2][4][2];
    if constexpr (epi_has_init<Epi>::value) E.init(acc, cur, wr, wc, fr, fq);
    else {
#pragma unroll
    for (int a = 0; a < 2; ++a)
#pragma unroll
        for (int b = 0; b < 2; ++b)
#pragma unroll
            for (int m = 0; m < 4; ++m)
#pragma unroll
                for (int n = 0; n < 2; ++n) acc[a][b][m][n] = (f32x4){0.f, 0.f, 0.f, 0.f};
    }
    bf16x8 At[4][2], B0[2][2], B1[2][2];
    const char* cA = (const char*)g.A + (size_t)cur.pm * tstepA; const char* cB = (const char*)g.Bt + (size_t)cur.pn * tstepB;
    S.a_ready(cur);
    if constexpr (SP2) {
        PG8_STAGE(PG8_SB(0, 0), cB, voffB); PG8_STAGE(PG8_SB(0, 1), cB + hstepB, voffB); PG8_STAGE(PG8_SA(0, 0), cA, voffA); PG8_STAGE(PG8_SA(0, 1), cA + hstepA, voffA);
        if (wr == 1) PG8_BAR;
        PG8_WAIT_V(2); PG8_BAR;
        PG8_STAGE(PG8_SB(1, 0), cB + kstep, voffB); PG8_STAGE(PG8_SA(1, 0), cA + kstep, voffA); PG8_STAGE(PG8_SB(1, 1), cB + hstepB + kstep, voffB);
        PG8_WAIT_V(6); PG8_BAR;
    } else {
        PG8_STAGE(PG8_SB(0, 0), cB, voffB); PG8_STAGE(PG8_SA(0, 0), cA, voffA); PG8_STAGE(PG8_SB(0, 1), cB + hstepB, voffB); PG8_STAGE(PG8_SA(0, 1), cA + hstepA, voffA);
        if (wr == 1) PG8_BAR;
        PG8_WAIT_V(4); PG8_BAR;
        PG8_STAGE(PG8_SB(1, 0), cB + kstep, voffB); PG8_STAGE(PG8_SA(1, 0), cA + kstep, voffA); PG8_STAGE(PG8_SB(1, 1), cB + hstepB + kstep, voffB);
        PG8_WAIT_V(6); PG8_BAR;
    }
    for (;;) {
        const bool has_next = S.next(ui + 1, nxt);
        const char* nA = has_next ? (const char*)g.A + (size_t)nxt.pm * tstepA : cA; const char* nB = has_next ? (const char*)g.Bt + (size_t)nxt.pn * tstepB : cB;
        for (int t = 0; t < nt; t += 2) {
            const bool last = (t == nt - 2);
            const char* a1 = cA + (size_t)(t + 1) * kstep;
            const char* a2 = last ? nA : cA + (size_t)(t + 2) * kstep; const char* b2 = last ? nB : cB + (size_t)(t + 2) * kstep;
            const char* a3 = a2 + kstep; const char* b3 = b2 + kstep;
            if (last && has_next) S.a_ready(nxt);
            if constexpr (epi_has_hook<Epi>::value) { if (t == 16 || t == 32) { f32x4 (&acc_)[2][2][4][2] = acc; E.hook(acc_, cur, t >> 4, wr, wc, fr, fq); } }
            if constexpr (SP2) {
            PG8_LDB(B0, 0, 0); PG8_LDB(B1, 0, 1); PG8_SCHED; PG8_LDA(At, 0, 0); PG8_STAGE(PG8_SA(1, 1), a1 + hstepA, voffA);
            PG8_WAIT_V(8); PG8_WAIT_L(0); PG8_BAR; PG8_MMA(0, 0, At, B0); PG8_MMA(0, 1, At, B1); PG8_BAR; PG8_SCHED;
            PG8_LDA(At, 0, 1); PG8_STAGE(PG8_SB(0, 0), b2, voffB); PG8_STAGE(PG8_SB(0, 1), b2 + hstepB, voffB); PG8_STAGE(PG8_SA(0, 0), a2, voffA);
            PG8_WAIT_V(8); PG8_WAIT_L(0); PG8_BAR; PG8_MMA(1, 0, At, B0); PG8_MMA(1, 1, At, B1); PG8_BAR; PG8_SCHED;
            PG8_LDB(B0, 1, 0); PG8_LDB(B1, 1, 1); PG8_SCHED; PG8_LDA(At, 1, 0); PG8_STAGE(PG8_SA(0, 1), a2 + hstepA, voffA);
            PG8_WAIT_V(8); PG8_WAIT_L(0); PG8_BAR; PG8_MMA(0, 0, At, B0); PG8_MMA(0, 1, At, B1); PG8_BAR; PG8_SCHED;
            PG8_LDA(At, 1, 1); PG8_STAGE(PG8_SB(1, 0), b3, voffB); PG8_STAGE(PG8_SB(1, 1), b3 + hstepB, voffB); PG8_STAGE(PG8_SA(1, 0), a3, voffA);
            PG8_WAIT_V(8); PG8_WAIT_L(0); PG8_BAR; PG8_MMA(1, 0, At, B0); PG8_MMA(1, 1, At, B1); PG8_BAR; PG8_SCHED;
            } else {
            PG8_LDB(B0, 0, 0); PG8_SCHED; PG8_LDA(At, 0, 0); PG8_STAGE(PG8_SA(1, 1), a1 + hstepA, voffA);
            PG8_WAIT_L(8); PG8_BAR; PG8_WAIT_L(0); PG8_MMA(0, 0, At, B0); PG8_BAR; PG8_SCHED;
            PG8_LDB(B1, 0, 1); PG8_STAGE(PG8_SB(0, 0), b2, voffB);
            PG8_BAR; PG8_WAIT_L(0); PG8_MMA(0, 1, At, B1); PG8_BAR;
            PG8_LDA(At, 0, 1); PG8_STAGE(PG8_SA(0, 0), a2, voffA);
            PG8_BAR; PG8_WAIT_L(0); PG8_MMA(1, 0, At, B0); PG8_BAR; PG8_SCHED;
            PG8_STAGE(PG8_SB(0, 1), b2 + hstepB, voffB);
            PG8_WAIT_V(6); PG8_BAR; PG8_MMA(1, 1, At, B1); PG8_BAR;
            PG8_LDB(B0, 1, 0); PG8_SCHED; PG8_LDA(At, 1, 0); PG8_STAGE(PG8_SA(0, 1), a2 + hstepA, voffA);
            PG8_WAIT_L(8); PG8_BAR; PG8_WAIT_L(0); PG8_MMA(0, 0, At, B0); PG8_BAR; PG8_SCHED;
            PG8_LDB(B1, 1, 1); PG8_STAGE(PG8_SB(1, 0), b3, voffB);
            PG8_BAR; PG8_WAIT_L(0); PG8_MMA(0, 1, At, B1); PG8_BAR;
            PG8_LDA(At, 1, 1); PG8_STAGE(PG8_SA(1, 0), a3, voffA);
            PG8_BAR; PG8_WAIT_L(0); PG8_MMA(1, 0, At, B0); PG8_BAR; PG8_SCHED;
            PG8_STAGE(PG8_SB(1, 1), b3 + hstepB, voffB);
            PG8_WAIT_V(6); PG8_BAR; PG8_MMA(1, 1, At, B1); PG8_BAR;
            }
        }
        if constexpr (ALIGN_EPI) { if (wr == 0) PG8_BAR; }
        if constexpr (!Epi::AFTER_DRAIN) { E(acc, cur, wr, wc, fr, fq); S.done(cur); }
        if (!has_next) break;
        if constexpr (epi_has_init<Epi>::value) E.init(acc, nxt, wr, wc, fr, fq);
        else {
#pragma unroll
        for (int a = 0; a < 2; ++a)
#pragma unroll
            for (int b = 0; b < 2; ++b)
#pragma unroll
                for (int m = 0; m < 4; ++m)
#pragma unroll
                    for (int n = 0; n < 2; ++n) acc[a][b][m][n] = (f32x4){0.f, 0.f, 0.f, 0.f};
        }
        cur = nxt; cA = nA; cB = nB; ++ui;
        if constexpr (ALIGN_EPI) { if (wr == 1) PG8_BAR; }
    }
    PG8_WAIT_V(0);
    if constexpr (!ALIGN_EPI) { if (wr == 0) PG8_BAR; }
    PG8_BAR;
    if constexpr (Epi::AFTER_DRAIN) { E.fused(acc, cur, wr, wc, fr, fq, lds, wid, lane); S.done(cur); }
#undef PG8_SA
#undef PG8_SB
#undef PG8_STAGE
#undef PG8_LDA
#undef PG8_LDB
#undef PG8_MMA
#undef PG8_WAIT_V
#undef PG8_WAIT_L
#undef PG8_BAR
#undef PG8_SCHED
}
template <class Epi, class Sched, bool ALIGN_EPI = false, bool SP2 = false>
__device__ __forceinline__ void gemm_phase(PG8_LAS unsigned char* lds, const Gemm g, const Sched& S, const Epi& E) { gemm_phase_ld<Epi, Sched, ALIGN_EPI, SP2>(lds, g, g.K, g.K, S, E); }
}

constexpr int NB = 4, SEQ = 4096, M = NB * SEQ, D = 2048, DEPTH = 4, BW = 1024;
constexpr int IN_TOTAL = 14352, NH = 14336;
constexpr int HC_U = 0, HC_GQ = 1024, HC_GK = 1536, HC_GV = 2048, HC_GG = 3072, HC_HQ = 4096, HC_HF = 5120, HC_HI = 6144, HC_HG = 7168, HC_MG = 8192;
constexpr int GLOW_COL = 3072;
constexpr int FF = 8192;
constexpr float DN_ALPHA = 1.681792830507429f;
constexpr float LN_EPS = 1e-5f, RMS_EPS = 1e-6f;
constexpr int NPH = 10;
constexpr int NBLK = SEQ / 16;
constexpr int BND_Q2 = 0, BND_K2T = 8704, BND_GL = 16896, BND_A2 = 17408, BND_BYTES = 20480, BND_ROW = 272;
constexpr int NPAIR = SEQ / 32;
constexpr int SLOT_VT = BND_BYTES, SLOT_BYTES = BND_BYTES + 4096;

constexpr size_t MiB = 1u << 20;
constexpr size_t WS_CTL = 0, CTL_ZERO_BYTES = 1 * MiB;
constexpr size_t WS_WIN = 1 * MiB;
constexpr size_t WS_WGLU = WS_WIN + 56 * MiB;
constexpr size_t WS_WUP = WS_WGLU + 2 * MiB;
constexpr size_t WS_WOUT = WS_WUP + 12 * MiB;
constexpr size_t WS_W1 = WS_WOUT + 8 * MiB;
constexpr size_t WS_W2 = WS_W1 + 32 * MiB;
constexpr size_t WS_XB = WS_W2 + 32 * MiB;
constexpr size_t WS_Y = WS_XB + 64 * MiB;
constexpr size_t WS_BND = WS_XB;
constexpr size_t WS_H = WS_Y + 128 * MiB;
constexpr size_t WS_Z = WS_H + 448 * MiB;
constexpr size_t WS_YCAT = WS_Z + 32 * MiB;
constexpr size_t WS_MERGED = WS_YCAT + 96 * MiB;
constexpr size_t WS_VT = WS_MERGED;
constexpr size_t WS_GLOW = WS_MERGED + 64 * MiB;
constexpr size_t WS_U = WS_GLOW + 1 * MiB;
constexpr size_t WS_S5W = WS_U + 32 * MiB;
constexpr size_t WS_S5TQ = WS_S5W + 16 * MiB;
constexpr size_t WS_S5C = WS_S5TQ + 48 * MiB;
constexpr size_t WS_WGLOW = WS_S5C + 1 * MiB;
constexpr size_t WS_Y2 = WS_WGLOW + 1 * MiB;
constexpr size_t WS_ST = WS_Y2 + 128 * MiB;
constexpr size_t WS_ID = WS_ST + 1 * MiB;
constexpr size_t WS_END = WS_ID + 1 * MiB;
static_assert((size_t)48 * NPAIR * BND_BYTES <= 192 * MiB, "bundles fit XB + Y");
constexpr int CW_BAR = 4096;

constexpr int NWAVES = 8;
constexpr int RING_BYTES = 131072, LDS_BYTES = 163840, LDSCTL_OFF = LDS_BYTES - 1024, MISC_OFF = LDSCTL_OFF + 320;

#define GAS __attribute__((address_space(1)))
#define LAS __attribute__((address_space(3)))
typedef unsigned short bf16;
typedef unsigned v4u __attribute__((ext_vector_type(4)));
typedef unsigned v2u __attribute__((ext_vector_type(2)));
typedef float f32x4 __attribute__((ext_vector_type(4)));
typedef short bf16x8 __attribute__((ext_vector_type(8)));
#define LDS_WAIT() asm volatile("s_waitcnt lgkmcnt(0)" ::: "memory")
__device__ __forceinline__ unsigned f2bf(float f) { unsigned u = __builtin_bit_cast(unsigned, f); return (u + 0x7fffu + ((u >> 16) & 1u)) >> 16; }
__device__ __forceinline__ unsigned pk2(float lo, float hi) { return f2bf(lo) | (f2bf(hi) << 16); }
typedef __bf16 bfx2_t __attribute__((ext_vector_type(2)));
typedef float f32x2_t __attribute__((ext_vector_type(2)));
__device__ __forceinline__ unsigned cvtpk(float lo, float hi) { const f32x2_t v = {lo, hi}; const bfx2_t b = __builtin_convertvector(v, bfx2_t); return __builtin_bit_cast(unsigned, b); }
typedef _Float16 f16x2_t __attribute__((ext_vector_type(2)));
__device__ __forceinline__ unsigned cvtpk_h(float lo, float hi) { const f32x2_t v = {lo, hi}; const f16x2_t h = __builtin_convertvector(v, f16x2_t); return __builtin_bit_cast(unsigned, h); }
__device__ __forceinline__ f32x2_t unpk_h(unsigned w) { const f16x2_t h = __builtin_bit_cast(f16x2_t, w); return __builtin_convertvector(h, f32x2_t); }
__device__ __forceinline__ float bf2f(bf16 v) { return __uint_as_float(((unsigned)v) << 16); }
__device__ __forceinline__ float bflo(unsigned w) { return __uint_as_float(w << 16); }
__device__ __forceinline__ float bfhi(unsigned w) { return __uint_as_float(w & 0xffff0000u); }
#define DPP_ADD(v, ctrl) ((v) + __builtin_bit_cast(float, __builtin_amdgcn_update_dpp(0, __builtin_bit_cast(int, (v)), (ctrl), 0xF, 0xF, false)))
__device__ __forceinline__ float row16_sum(float v) {
    v = DPP_ADD(v, 0xB1); v = DPP_ADD(v, 0x4E); v = DPP_ADD(v, 0x141); v = DPP_ADD(v, 0x140);
    return v;
}
__device__ __forceinline__ float wave_sum(float v) {
    v = row16_sum(v);
    const int vi = __builtin_bit_cast(int, v);
    return (__builtin_bit_cast(float, __builtin_amdgcn_readlane(vi, 0)) + __builtin_bit_cast(float, __builtin_amdgcn_readlane(vi, 16))) + (__builtin_bit_cast(float, __builtin_amdgcn_readlane(vi, 32)) + __builtin_bit_cast(float, __builtin_amdgcn_readlane(vi, 48)));
}
__device__ __forceinline__ float half_sum(float v, int lane) {
    const int vi = __builtin_bit_cast(int, row16_sum(v));
    const float lo = __builtin_bit_cast(float, __builtin_amdgcn_readlane(vi, 0)) + __builtin_bit_cast(float, __builtin_amdgcn_readlane(vi, 16)), hi = __builtin_bit_cast(float, __builtin_amdgcn_readlane(vi, 32)) + __builtin_bit_cast(float, __builtin_amdgcn_readlane(vi, 48));
    return (lane & 32) ? hi : lo;
}
__device__ __forceinline__ float sigm(float x) { return __builtin_amdgcn_rcpf(1.0f + __expf(-x)); }
__device__ __forceinline__ float gelu_tanh(float x) { const float u = 0.7978845608028654f * (x + 0.044715f * x * x * x); return 0.5f * x * (1.0f + tanhf(u)); }
__device__ __forceinline__ float logsigmoidf_(float z) { return fminf(z, 0.f) - log1pf(expf(-fabsf(z))); }
__device__ __forceinline__ bf16x8 mk8(unsigned a, unsigned b, unsigned c, unsigned d) { v4u t; t.x = a; t.y = b; t.z = c; t.w = d; return __builtin_bit_cast(bf16x8, t); }
#define MFMA16(a, b, c) __builtin_amdgcn_mfma_f32_16x16x32_bf16((a), (b), (c), 0, 0, 0)
typedef short bf16x4 __attribute__((ext_vector_type(4)));
#define MFMA16K(a, b, c) __builtin_amdgcn_mfma_f32_16x16x16bf16_1k((a), (b), (c), 0, 0, 0)

#define XB_TMO      128
#define XB_XCNT(j)  (256  + 64 * (j))
#define XB_XSUB(j)  (1280 + 64 * (j))
#define XB_XGEN(j)  (2304 + 64 * (j))
#define XB_TOP      3328
#define XB_TOPGEN   3392
#define XCD_BAR_WORDS 3456
#define XB_SPIN_CAP (1u << 18)
__device__ __forceinline__ unsigned xb_ld(unsigned* p)              { return __hip_atomic_load(p, __ATOMIC_RELAXED, __HIP_MEMORY_SCOPE_AGENT); }
__device__ __forceinline__ unsigned xb_add(unsigned* p, unsigned v) { return __hip_atomic_fetch_add(p, v, __ATOMIC_RELAXED, __HIP_MEMORY_SCOPE_AGENT); }
__device__ __forceinline__ unsigned xb_xcc_id() { return (unsigned)__builtin_amdgcn_s_getreg((3 << 11) | 20) & 0xFu; }
#define XB_SPIN(cond, bar) do { unsigned _sp = 0; while (cond) { __builtin_amdgcn_s_sleep(1); \
    if ((++_sp & 255u) == 0u) { if (xb_ld(&(bar)[XB_TMO])) break; if (_sp > XB_SPIN_CAP) { atomicAdd(&(bar)[XB_TMO], 1u); break; } } } } while (0)
struct XcdBarrier { unsigned* bar; unsigned x; volatile LAS unsigned* st; };
__device__ __forceinline__ XcdBarrier xcd_barrier_post(unsigned* bar, volatile LAS unsigned* st) {
    XcdBarrier b; b.bar = bar; b.x = xb_xcc_id(); b.st = st;
    if (threadIdx.x == 0) (void)xb_add(&bar[XB_XCNT(b.x)], 1u);
    return b;
}
__device__ __forceinline__ void xcd_barrier_complete(unsigned* bar, unsigned x, unsigned& nloc, unsigned& nx) {
    const unsigned G = gridDim.x * gridDim.y * gridDim.z;
    unsigned sum, cnt, mine, sp = 0u;
    for (;;) {
        sum = 0u; cnt = 0u; mine = 0u;
#pragma unroll
        for (unsigned j = 0; j < 16; ++j) { const unsigned c = xb_ld(&bar[XB_XCNT(j)]); sum += c; cnt += (c > 0u) ? 1u : 0u; mine = (j == x) ? c : mine; }
        if (sum == G) break;
        __builtin_amdgcn_s_sleep(1);
        if ((++sp & 255u) == 0u) { if (xb_ld(&bar[XB_TMO])) break; if (sp > XB_SPIN_CAP) { atomicAdd(&bar[XB_TMO], 1u); break; } }
    }
    nloc = mine > 0u ? mine : 1u; nx = cnt > 0u ? cnt : 1u;
}
__device__ __forceinline__ void xcd_barrier(const XcdBarrier& b) {
    asm volatile("s_waitcnt vmcnt(0)" ::: "memory");
    __syncthreads();
    if (threadIdx.x == 0) {
        unsigned* bar = b.bar;
        __builtin_amdgcn_s_waitcnt(0);
        unsigned nloc = b.st[0], nx = b.st[1];
        if (nloc == 0u) { xcd_barrier_complete(bar, b.x, nloc, nx); b.st[0] = nloc; b.st[1] = nx; }
        const unsigned old = xb_add(&bar[XB_XSUB(b.x)], 1u);
        const unsigned gen = old / nloc;
        if (old + 1u == (gen + 1u) * nloc) {
            __builtin_amdgcn_fence(__ATOMIC_RELEASE, "agent");
            asm volatile("s_waitcnt vmcnt(0)" ::: "memory");
            const unsigned og = xb_add(&bar[XB_TOP], 1u);
            const unsigned tg = og / nx;
            if (og + 1u == (tg + 1u) * nx) xb_add(&bar[XB_TOPGEN], 1u);
            else XB_SPIN(xb_ld(&bar[XB_TOPGEN]) == tg, bar);
            __builtin_amdgcn_fence(__ATOMIC_ACQUIRE, "agent");
            xb_add(&bar[XB_XGEN(b.x)], 1u);
            asm volatile("s_waitcnt vmcnt(0)" ::: "memory");
        } else {
            XB_SPIN(xb_ld(&bar[XB_XGEN(b.x)]) == gen, bar);
            __builtin_amdgcn_fence(__ATOMIC_ACQUIRE, "agent");
            asm volatile("s_waitcnt vmcnt(0)" ::: "memory");
        }
    }
    __syncthreads();
}

struct Args { const float* in[25]; float* out; unsigned char* ws; int ph_lo, ph_hi, bar_idx, pad; };
enum { I_X = 0, I_WIN, I_LAMRE, I_LAMIM, I_LOGDT, I_BRE, I_BIM, I_CRE, I_CIM, I_S5D, I_WGLU, I_BGLU, I_GWG, I_GBG, I_GNW, I_LBL, I_HNW, I_WUP, I_WOUT, I_LN1G, I_LN1B, I_LN2G, I_LN2B, I_W1, I_W2 };

__device__ __forceinline__ void cvt_item(const float* src, int ld_src, int c0, bf16* dst, int ld_dst, int row_off, int koff, int nblk, int item, LAS float* scr, int lane) {
    const int kb = item / nblk, nb = item % nblk, k0 = 64 * kb, n0 = 32 * nb;
    {
        const int kr = lane >> 3, q = lane & 7; const GAS float* sp = (const GAS float*)src + (size_t)(k0 + kr) * ld_src + c0 + n0 + 4 * q;
        f32x4 v[8];
#pragma unroll
        for (int i = 0; i < 8; ++i) v[i] = *(const GAS f32x4*)(sp + (size_t)(8 * i) * ld_src);
#pragma unroll
        for (int i = 0; i < 8; ++i) *(LAS f32x4*)(scr + (8 * i + kr) * 36 + 4 * q) = v[i];
    }
    LDS_WAIT(); asm volatile("" ::: "memory");
    const int c = lane & 7;
#pragma unroll
    for (int j = 0; j < 4; ++j) { const int n = (lane >> 3) + 8 * j; const LAS float* s = scr + (8 * c) * 36 + n;
        v4u o; o.x = pk2(s[0 * 36], s[1 * 36]); o.y = pk2(s[2 * 36], s[3 * 36]); o.z = pk2(s[4 * 36], s[5 * 36]); o.w = pk2(s[6 * 36], s[7 * 36]);
        *(GAS v4u*)(dst + (size_t)(row_off + n0 + n) * ld_dst + koff + k0 + 8 * c) = o; }
    LDS_WAIT(); asm volatile("" ::: "memory");
}

__device__ __forceinline__ void ln_phase(const bf16* Y, const float* g, const float* b, float* out, bf16* xb, float* st, int gw, int NGW, int lane) {
    v4u nv[4];
    if (gw < M) { const GAS v4u* yr = (const GAS v4u*)(Y + (size_t)gw * D) + lane;
#pragma unroll
        for (int j = 0; j < 4; ++j) nv[j] = yr[64 * j]; }
    for (int m = gw; m < M; m += NGW) {
        f32x4 v[8]; float s = 0.f;
#pragma unroll
        for (int j = 0; j < 4; ++j) { const f32x2_t a = unpk_h(nv[j].x), b2 = unpk_h(nv[j].y), c = unpk_h(nv[j].z), d = unpk_h(nv[j].w); v[2 * j] = (f32x4){a.x, a.y, b2.x, b2.y}; v[2 * j + 1] = (f32x4){c.x, c.y, d.x, d.y}; }
        { const int mn = m + NGW < M ? m + NGW : m; const GAS v4u* yr = (const GAS v4u*)(Y + (size_t)mn * D) + lane;
#pragma unroll
          for (int j = 0; j < 4; ++j) nv[j] = yr[64 * j]; }
#pragma unroll
        for (int j = 0; j < 8; ++j) s += (v[j][0] + v[j][1]) + (v[j][2] + v[j][3]);
        const float mean = wave_sum(s) * (1.0f / D); float s2 = 0.f;
#pragma unroll
        for (int j = 0; j < 8; ++j) { v[j] = v[j] - mean; s2 += (v[j][0] * v[j][0] + v[j][1] * v[j][1]) + (v[j][2] * v[j][2] + v[j][3] * v[j][3]); }
        const float rstd = rsqrtf(wave_sum(s2) * (1.0f / D) + LN_EPS);
        if (out) {
            GAS f32x4* orow = (GAS f32x4*)(out + (size_t)m * D) + 2 * lane;
#pragma unroll
            for (int j = 0; j < 8; ++j) { const int c4 = 2 * lane + 128 * (j >> 1) + (j & 1); const f32x4 gg = ((const f32x4*)g)[c4], bb = ((const f32x4*)b)[c4]; orow[128 * (j >> 1) + (j & 1)] = v[j] * rstd * gg + bb; }
        } else {
            if (lane == 0) { st[2 * (size_t)m] = mean; st[2 * (size_t)m + 1] = rstd; }
            GAS v4u* o16 = (GAS v4u*)(xb + (size_t)m * D) + lane;
#pragma unroll
            for (int j = 0; j < 4; ++j) { const int c4 = 2 * lane + 128 * j; const f32x4 g0 = ((const f32x4*)g)[c4], b0 = ((const f32x4*)b)[c4], g1 = ((const f32x4*)g)[c4 + 1], b1 = ((const f32x4*)b)[c4 + 1];
                const f32x4 o0 = v[2 * j] * rstd * g0 + b0, o1 = v[2 * j + 1] * rstd * g1 + b1;
                v4u w; w.x = cvtpk(o0[0], o0[1]); w.y = cvtpk(o0[2], o0[3]); w.z = cvtpk(o1[0], o1[1]); w.w = cvtpk(o1[2], o1[3]);
                o16[64 * j] = w; }
        }
    }
}

__device__ __forceinline__ void cpow_(double revd, float lrdt, int m, float& re, float& im) {
    double a = revd * (double)m; a -= rint(a);
    const float mag = __expf(lrdt * (float)m), af = (float)a; re = mag * __builtin_amdgcn_cosf(af); im = mag * __builtin_amdgcn_sinf(af);
}
__device__ __forceinline__ void s5_build(const Args& args, int l, int g, bf16* WgT, bf16* TQ, float* S5C, LAS unsigned char* lds, int tid) {
    LAS double* angd = (LAS double*)lds;
    LAS float* lrdt = (LAS float*)(lds + 512);
    LAS float* bbr = lrdt + 64;
    LAS float* bbi = bbr + 1024;
    LAS float* car = bbi + 1024;
    LAS float* cai = car + 1024;
    LAS float* ktab = cai + 1024;
    __syncthreads();
    if (tid < 64) {
        const int p = tid;
        const float lr = fminf(args.in[I_LAMRE][(l * 64 + g) * 64 + p], -1e-4f), li = args.in[I_LAMIM][(l * 64 + g) * 64 + p];
        const float dt = expf(args.in[I_LOGDT][l * 64 + g]);
        const double rev = (double)li * (double)dt * 0.15915494309189533577;
        angd[p] = rev; lrdt[p] = lr * dt;
        float ar, ai; cpow_(rev, lr * dt, 1, ar, ai);
        const float den = lr * lr + li * li;
        const float fre = ((ar - 1.0f) * lr + ai * li) / den, fim = (ai * lr - (ar - 1.0f) * li) / den;
#pragma unroll
        for (int c = 0; c < 16; ++c) { const float br = args.in[I_BRE][((size_t)(l * 64 + g) * 64 + p) * 16 + c], bi = args.in[I_BIM][((size_t)(l * 64 + g) * 64 + p) * 16 + c];
            bbr[p * 16 + c] = fre * br - fim * bi; bbi[p * 16 + c] = fre * bi + fim * br; }
        float r16, i16, r512, i512; cpow_(rev, lr * dt, 16, r16, i16); cpow_(rev, lr * dt, 512, r512, i512);
        S5C[p] = r16; S5C[64 + p] = i16; S5C[128 + p] = r512; S5C[192 + p] = i512;
    }
    __syncthreads();
    {
        const int p = tid & 63, jj = tid >> 6;
#pragma unroll
        for (int h = 0; h < 2; ++h) { const int j = jj + 8 * h; float pr, pi; cpow_(angd[p], lrdt[p], 15 - j, pr, pi);
            unsigned wr[8], wi[8];
#pragma unroll
            for (int c = 0; c < 16; c += 2) { const float r0 = pr * bbr[p * 16 + c] - pi * bbi[p * 16 + c], i0 = pr * bbi[p * 16 + c] + pi * bbr[p * 16 + c];
                const float r1 = pr * bbr[p * 16 + c + 1] - pi * bbi[p * 16 + c + 1], i1 = pr * bbi[p * 16 + c + 1] + pi * bbr[p * 16 + c + 1];
                wr[c >> 1] = pk2(r0, r1); wi[c >> 1] = pk2(i0, i1); }
            v4u* dr = (v4u*)(WgT + (size_t)p * 256 + j * 16); v4u* di = (v4u*)(WgT + (size_t)(64 + p) * 256 + j * 16);
            v4u t; t.x = wr[0]; t.y = wr[1]; t.z = wr[2]; t.w = wr[3]; dr[0] = t; t.x = wr[4]; t.y = wr[5]; t.z = wr[6]; t.w = wr[7]; dr[1] = t;
            t.x = wi[0]; t.y = wi[1]; t.z = wi[2]; t.w = wi[3]; di[0] = t; t.x = wi[4]; t.y = wi[5]; t.z = wi[6]; t.w = wi[7]; di[1] = t; }
    }
    for (int tau = 0; tau <= 16; ++tau) {
        __syncthreads();
#pragma unroll
        for (int h = 0; h < 2; ++h) { const int e = tid + 512 * h, c = e >> 6, p = e & 63;
            float pr, pi; cpow_(angd[p], lrdt[p], tau, pr, pi);
            const float cr = args.in[I_CRE][((size_t)(l * 64 + g) * 16 + c) * 64 + p], ci = args.in[I_CIM][((size_t)(l * 64 + g) * 16 + c) * 64 + p];
            const float mr = cr * pr - ci * pi, mi = cr * pi + ci * pr;
            car[e] = mr; cai[e] = mi;
            if (tau >= 1) { const int n = (tau - 1) * 16 + c; TQ[(size_t)n * 384 + 256 + p] = (bf16)f2bf(mr); TQ[(size_t)n * 384 + 320 + p] = (bf16)f2bf(-mi); } }
        __syncthreads();
        if (tau < 16 && tid < 256) { const int c = tid >> 4, c2 = tid & 15; float s = 0.f;
            for (int p = 0; p < 64; ++p) s += car[c * 64 + p] * bbr[p * 16 + c2] - cai[c * 64 + p] * bbi[p * 16 + c2];
            ktab[tau * 256 + c * 16 + c2] = s; }
    }
    __syncthreads();
    {
        const int n = tid >> 1, i = n >> 4, c = n & 15, hf = tid & 1;
#pragma unroll
        for (int jj = 0; jj < 8; ++jj) { const int j = hf * 8 + jj; unsigned w[8];
#pragma unroll
            for (int c2 = 0; c2 < 16; c2 += 2) { float a = 0.f, b = 0.f; if (i >= j) { a = ktab[(i - j) * 256 + c * 16 + c2]; b = ktab[(i - j) * 256 + c * 16 + c2 + 1]; } w[c2 >> 1] = pk2(a, b); }
            v4u* d = (v4u*)(TQ + (size_t)n * 384 + j * 16); v4u t; t.x = w[0]; t.y = w[1]; t.z = w[2]; t.w = w[3]; d[0] = t; t.x = w[4]; t.y = w[5]; t.z = w[6]; t.w = w[7]; d[1] = t; }
    }
    __syncthreads();
}

constexpr int S5_VS = 132;
constexpr int S5_WROW = 528, S5_TROW = 784;
__device__ __forceinline__ float gelu_fast(float x) { return x * sigm(1.5957691216057308f * (x + 0.044715f * x * x * x)); }
__device__ __forceinline__ void s5_unit(const bf16* Ubg, const bf16* WgT, const bf16* TQ, const float* S5C, const float* dsk, bf16* Zbg, LAS unsigned char* lds, int tid) {
    const int lane = tid & 63, wave = __builtin_amdgcn_readfirstlane(tid >> 6), r = lane & 15, kg = lane >> 4;
    LAS float* V = (LAS float*)lds; LAS float* CAR = V + 256 * S5_VS;
    __syncthreads();
    { const unsigned char* gsrc = (const unsigned char*)WgT + (size_t)(tid >> 5) * 512 + (tid & 31) * 16; LAS unsigned char* ldst = lds + (tid >> 5) * S5_WROW + (tid & 31) * 16;
#pragma unroll
      for (int i = 0; i < 8; ++i) *(LAS v4u*)(ldst + i * 16 * S5_WROW) = *(const v4u*)(gsrc + i * 16 * 512); }
    bf16x8 ua[2][8];
#pragma unroll
    for (int mt = 0; mt < 2; ++mt)
#pragma unroll
        for (int ks = 0; ks < 8; ++ks) ua[mt][ks] = *(const bf16x8*)(Ubg + (size_t)(32 * wave + 16 * mt + r) * 256 + 32 * ks + 8 * kg);
    __syncthreads();
    {
        f32x4 acc[2][8];
#pragma unroll
        for (int mt = 0; mt < 2; ++mt)
#pragma unroll
            for (int nt = 0; nt < 8; ++nt) acc[mt][nt] = (f32x4){0.f, 0.f, 0.f, 0.f};
#pragma unroll
        for (int ks = 0; ks < 8; ++ks)
#pragma unroll
            for (int nt = 0; nt < 8; ++nt) { const bf16x8 b = *(const LAS bf16x8*)(lds + (16 * nt + r) * S5_WROW + ks * 64 + kg * 16);
#pragma unroll
                for (int mt = 0; mt < 2; ++mt) acc[mt][nt] = MFMA16(b, ua[mt][ks], acc[mt][nt]);
                if (nt == 7) __builtin_amdgcn_sched_barrier(0); }
        __syncthreads();
#pragma unroll
        for (int mt = 0; mt < 2; ++mt)
#pragma unroll
            for (int nt = 0; nt < 8; ++nt) *(LAS f32x4*)(V + (32 * wave + 16 * mt + r) * S5_VS + 16 * nt + 4 * kg) = acc[mt][nt];
    }
    bf16x8 sa[2][4];
    {
        const float a16r = S5C[lane], a16i = S5C[64 + lane], a5r = S5C[128 + lane], a5i = S5C[192 + lane];
        asm volatile("s_waitcnt lgkmcnt(0)" ::: "memory");
        float vr[32], vi[32];
#pragma unroll
        for (int q = 0; q < 32; ++q) { vr[q] = V[(32 * wave + q) * S5_VS + lane]; vi[q] = V[(32 * wave + q) * S5_VS + 64 + lane]; }
        float sr = 0.f, si = 0.f;
#pragma unroll
        for (int q = 0; q < 32; ++q) { const float tr = vr[q], ti = vi[q]; vr[q] = sr; vi[q] = si; const float nr = a16r * sr - a16i * si + tr, ni = a16r * si + a16i * sr + ti; sr = nr; si = ni; }
        CAR[wave * 128 + lane] = sr; CAR[wave * 128 + 64 + lane] = si;
        __syncthreads();
        float cr = 0.f, ci = 0.f;
        for (int w2 = 0; w2 < wave; ++w2) { const float er = CAR[w2 * 128 + lane], ei = CAR[w2 * 128 + 64 + lane]; const float nr = a5r * cr - a5i * ci + er, ni = a5r * ci + a5i * cr + ei; cr = nr; ci = ni; }
        float pr = 1.f, pi = 0.f;
        LAS bf16* SP = (LAS bf16*)lds;
#pragma unroll
        for (int q = 0; q < 32; ++q) { const float xr = vr[q] + pr * cr - pi * ci, xi = vi[q] + pr * ci + pi * cr;
            SP[(32 * wave + q) * 264 + lane] = (bf16)f2bf(xr); SP[(32 * wave + q) * 264 + 64 + lane] = (bf16)f2bf(xi);
            const float nr = pr * a16r - pi * a16i, ni = pr * a16i + pi * a16r; pr = nr; pi = ni; }
        asm volatile("s_waitcnt lgkmcnt(0)" ::: "memory");
#pragma unroll
        for (int mt = 0; mt < 2; ++mt)
#pragma unroll
            for (int k2 = 0; k2 < 4; ++k2) sa[mt][k2] = *(const LAS bf16x8*)(lds + (32 * wave + 16 * mt + r) * S5_WROW + k2 * 64 + kg * 16);
    }
    const f32x4 dv = *(const f32x4*)(dsk + 4 * kg);
#pragma unroll 1
    for (int nh = 0; nh < 2; ++nh) {
        asm volatile("s_waitcnt lgkmcnt(0)" ::: "memory");
        __syncthreads();
        { const unsigned char* gsrc = (const unsigned char*)TQ + (size_t)(128 * nh + (tid >> 2)) * 768 + (tid & 3) * 192; LAS unsigned char* ldst = lds + (tid >> 2) * S5_TROW + (tid & 3) * 192;
#pragma unroll
          for (int i = 0; i < 12; ++i) *(LAS v4u*)(ldst + i * 16) = *(const v4u*)(gsrc + i * 16); }
        __syncthreads();
        f32x4 acc[2][8];
#pragma unroll
        for (int mt = 0; mt < 2; ++mt)
#pragma unroll
            for (int nt = 0; nt < 8; ++nt) acc[mt][nt] = (f32x4){0.f, 0.f, 0.f, 0.f};
#pragma unroll
        for (int ks = 0; ks < 12; ++ks)
#pragma unroll
            for (int nt = 0; nt < 8; ++nt) { const bf16x8 b = *(const LAS bf16x8*)(lds + (16 * nt + r) * S5_TROW + ks * 64 + kg * 16);
#pragma unroll
                for (int mt = 0; mt < 2; ++mt) acc[mt][nt] = MFMA16(b, ks < 8 ? ua[mt][ks < 8 ? ks : 0] : sa[mt][ks < 8 ? 0 : ks - 8], acc[mt][nt]);
                if (nt == 7) __builtin_amdgcn_sched_barrier(0); }
#pragma unroll
        for (int mt = 0; mt < 2; ++mt)
#pragma unroll
            for (int nt = 0; nt < 8; ++nt) { const int i = 8 * nh + nt, kb = 32 * wave + 16 * mt + r, s = 16 * kb + i;
                const v2u uu = *(const v2u*)(Ubg + (size_t)s * 16 + 4 * kg);
                const f32x4 a = acc[mt][nt];
                const float y0 = a[0] + dv[0] * bflo(uu.x), y1 = a[1] + dv[1] * bfhi(uu.x), y2 = a[2] + dv[2] * bflo(uu.y), y3 = a[3] + dv[3] * bfhi(uu.y);
                v2u o; o.x = cvtpk(gelu_fast(y0), gelu_fast(y1)); o.y = cvtpk(gelu_fast(y2), gelu_fast(y3));
                *(v2u*)(Zbg + (size_t)s * BW + 4 * kg) = o; }
    }
    __syncthreads();
}

__device__ __forceinline__ void glow_tile(const bf16* XB, const bf16* WglowT, float* GLOW, int row0, int lane) {
    const int r = lane & 15, kg = lane >> 4;
    f32x4 acc = (f32x4){0.f, 0.f, 0.f, 0.f};
#pragma unroll 16
    for (int ks = 0; ks < D / 32; ++ks) {
        const bf16x8 a = *(const bf16x8*)(XB + (size_t)(row0 + r) * D + 32 * ks + 8 * kg);
        const bf16x8 b = *(const bf16x8*)(WglowT + (size_t)r * D + 32 * ks + 8 * kg);
        acc = MFMA16(a, b, acc);
    }
#pragma unroll
    for (int j = 0; j < 4; ++j) GLOW[(size_t)(row0 + 4 * kg + j) * 16 + r] = acc[j];
}

__device__ __forceinline__ int kperm(int kk) { const int o = kk & 31; return (kk & ~31) + 8 * ((o >> 2) & 3) + 4 * (o >> 4) + (o & 3); }

constexpr int PRP_INB = 36864, PRP_Q = 0, PRP_K = 16384, PRP_G = 32768, PRP_OUT = 2 * PRP_INB, PRP_KD = PRP_OUT + 2 * BND_BYTES, PRP_QU = PRP_KD + 4 * 16 * BND_ROW, PRP_GLX = PRP_QU + 2 * 16 * BND_ROW;
__device__ __forceinline__ void prep_dma(int u, int p, const bf16* H, const float* GLOW, LAS unsigned char* lds, int tid) {
    const int bhx = u >> 6, grp = u & 63; const bool gla = bhx < 16;
    const int b = gla ? (bhx >> 2) : ((bhx - 16) >> 3), h = gla ? (bhx & 3) : ((bhx - 16) & 7);
    const size_t row0 = (size_t)b * SEQ + (size_t)grp * 64;
    const int qcol = gla ? (HC_GQ + h * 128) : (HC_HQ + h * 128), kcol = gla ? (HC_GK + h * 128) : (HC_HF + h * 128);
    const int lane = tid & 63, w = __builtin_amdgcn_readfirstlane(tid >> 6), rl = lane >> 3, c8 = lane & 7;
    const bf16* hq = H + (row0 + 8 * w + rl) * NH;
    LAS unsigned char* dst = lds + p * PRP_INB;
#pragma unroll
    for (int j = 0; j < 2; ++j) {
        __builtin_amdgcn_global_load_lds((const unsigned*)(hq + qcol + (c8 + 8 * j) * 8), (LAS unsigned*)(dst + PRP_Q + j * 8192 + w * 1024), 16, 0, 0);
        __builtin_amdgcn_global_load_lds((const unsigned*)(hq + kcol + (c8 + 8 * j) * 8), (LAS unsigned*)(dst + PRP_K + j * 8192 + w * 1024), 16, 0, 0); }
    if (w < 4) __builtin_amdgcn_global_load_lds((const unsigned*)(GLOW + (row0 + 16 * w + (lane >> 2)) * 16 + (lane & 3) * 4), (LAS unsigned*)(dst + PRP_G + w * 1024), 16, 0, 0);
}
__device__ __forceinline__ void prep_unit(const Args& args, int l, int u, int unext, int p, const bf16* H, const float* GLOW, unsigned char* BND, LAS unsigned char* lds, int tid) {
    const int bhx = u >> 6, grp = u & 63, kk = tid & 127, bl = tid >> 7;
    const bool gla = bhx < 16;
    const int h = gla ? (bhx & 3) : ((bhx - 16) & 7);
    asm volatile("s_waitcnt vmcnt(0)" ::: "memory");
    __syncthreads();
    if (unext < 48 * 64) prep_dma(unext, p ^ 1, H, GLOW, lds, tid);
    const LAS unsigned char* inb = lds + p * PRP_INB;
    float q[16], k[16], G[16];
    const LAS bf16* sq = (const LAS bf16*)(inb + PRP_Q + (kk >> 6) * 8192) + (16 * bl) * 64 + (kk & 63); const LAS bf16* sk = (const LAS bf16*)(inb + PRP_K + (kk >> 6) * 8192) + (16 * bl) * 64 + (kk & 63);
    if (gla) {
        float wg[16];
#pragma unroll
        for (int r = 0; r < 16; ++r) wg[r] = args.in[I_GWG][((size_t)l * 16 + r) * 512 + h * 128 + kk];
        const float bg = args.in[I_GBG][l * 512 + h * 128 + kk];
        float run = 0.f;
#pragma unroll
        for (int i = 0; i < 16; ++i) { const LAS f32x4* gp = (const LAS f32x4*)(inb + PRP_G + (16 * bl + i) * 64); float z = bg;
#pragma unroll
            for (int r4 = 0; r4 < 4; ++r4) { const f32x4 gv = gp[r4]; z += gv[0] * wg[4 * r4] + gv[1] * wg[4 * r4 + 1] + gv[2] * wg[4 * r4 + 2] + gv[3] * wg[4 * r4 + 3]; }
            const float ls = fminf(z, 0.f) - __logf(1.0f + __expf(-fabsf(z)));
            run += fmaxf(ls * (1.0f / 16.0f), -100.f); G[i] = run;
            q[i] = bf2f(sq[i * 64]) * 0.08838834764831845f; k[i] = bf2f(sk[i * 64]); }
    } else {
        float lbv;
        { float lg[4], mx = -1e30f;
#pragma unroll
          for (int t = 0; t < 4; ++t) { lg[t] = args.in[I_LBL][t * 1024 + h * 128 + kk]; mx = fmaxf(mx, lg[t]); }
          float e[4], se = 0.f;
#pragma unroll
          for (int t = 0; t < 4; ++t) { e[t] = __expf(lg[t] - mx); se += e[t]; }
          float cs = 0.f;
#pragma unroll
          for (int t = 1; t < 4; ++t) if (t <= l) cs += e[t] / se;
          lbv = cs; }
        float run = 0.f;
#pragma unroll
        for (int i = 0; i < 16; ++i) { const float fl = bf2f(sk[i * 64]); const float f = lbv + (1.0f - lbv) * sigm(fl);
            run += fmaxf(__logf(f), -100.f); G[i] = run; k[i] = 1.0f - f;
            const float qv = bf2f(sq[i * 64]); q[i] = qv * sigm(qv); }
    }
    const int pr = bl >> 1, hf = bl & 1;
    LAS unsigned char* img = lds + PRP_OUT + pr * BND_BYTES; LAS unsigned char* kds = lds + PRP_KD + bl * (16 * BND_ROW); LAS unsigned char* qus = lds + PRP_QU + pr * (16 * BND_ROW);
    LAS float* glx = (LAS float*)(lds + PRP_GLX);
    const int pos = kperm(kk);
    const float Gl = G[15], GLs = __expf(Gl);
    glx[bl * 128 + kk] = GLs;
    __syncthreads();
    const float GLp = glx[(bl ^ 1) * 128 + kk];
    unsigned kh[8];
#pragma unroll
    for (int i = 0; i < 16; i += 2) {
        const float E0 = __expf(fmaxf(G[i], -80.f)), E1 = __expf(fmaxf(G[i + 1], -80.f));
        const float R0 = __builtin_amdgcn_rcpf(E0), R1 = __builtin_amdgcn_rcpf(E1);
        const float q0 = q[i] * E0, q1 = q[i + 1] * E1;
        *(LAS bf16*)(img + BND_Q2 + (16 * hf + i) * BND_ROW + pos * 2) = (bf16)f2bf(hf ? q0 * GLp : q0);
        *(LAS bf16*)(img + BND_Q2 + (16 * hf + i + 1) * BND_ROW + pos * 2) = (bf16)f2bf(hf ? q1 * GLp : q1);
        if (hf) { *(LAS bf16*)(qus + i * BND_ROW + pos * 2) = (bf16)f2bf(q0); *(LAS bf16*)(qus + (i + 1) * BND_ROW + pos * 2) = (bf16)f2bf(q1); }
        *(LAS bf16*)(kds + i * BND_ROW + pos * 2) = (bf16)f2bf(k[i] * R0);
        *(LAS bf16*)(kds + (i + 1) * BND_ROW + pos * 2) = (bf16)f2bf(k[i + 1] * R1);
        const float h0 = k[i] * __expf(Gl - G[i]), h1 = k[i + 1] * __expf(Gl - G[i + 1]);
        kh[i >> 1] = hf ? pk2(h0, h1) : pk2(h0 * GLp, h1 * GLp);
    }
    { LAS unsigned char* d = img + BND_K2T + kk * 64; const int hs = (-(kk >> 2)) & 3; v4u t; t.x = kh[0]; t.y = kh[1]; t.z = kh[2]; t.w = kh[3]; *(LAS v4u*)(d + ((2 * hf) ^ hs) * 16) = t; t.x = kh[4]; t.y = kh[5]; t.z = kh[6]; t.w = kh[7]; *(LAS v4u*)(d + ((2 * hf + 1) ^ hs) * 16) = t; }
    if (hf == 0) *(LAS float*)(img + BND_GL + kk * 4) = GLs * GLp;
    { unsigned z0 = 0u; asm volatile("" : "+v"(z0));
      if (kk < 16) *(LAS v4u*)(img + BND_Q2 + (16 * hf + kk) * BND_ROW + 256) = (v4u){z0, z0, z0, z0};
      if (hf == 0 && kk < 16) { const int hs = (-(kk >> 2)) & 3; *(LAS v4u*)(img + BND_A2 + kk * 64 + (2 ^ hs) * 16) = (v4u){z0, z0, z0, z0}; *(LAS v4u*)(img + BND_A2 + kk * 64 + (3 ^ hs) * 16) = (v4u){z0, z0, z0, z0}; }
      if (hf == 1 && kk < 64) *(LAS v4u*)(img + BND_A2 + 2048 + kk * 16) = (v4u){z0, z0, z0, z0}; }
    __syncthreads();
    if (tid < 384) {
        const int w = tid >> 6, lane = tid & 63, r = lane & 15, kg = lane >> 4, p2 = w / 3, wh = w - 3 * p2;
        LAS unsigned char* im = lds + PRP_OUT + p2 * BND_BYTES;
        const LAS unsigned char* qsrc = wh == 0 ? im + BND_Q2 : wh == 1 ? im + BND_Q2 + 16 * BND_ROW : lds + PRP_QU + p2 * (16 * BND_ROW);
        const LAS unsigned char* kd = lds + PRP_KD + (2 * p2 + (wh == 2 ? 1 : 0)) * (16 * BND_ROW);
        f32x4 At = (f32x4){0.f, 0.f, 0.f, 0.f}, At2 = (f32x4){0.f, 0.f, 0.f, 0.f};
#pragma unroll
        for (int ks = 0; ks < 4; ++ks) { const bf16x8 qf = *(const LAS bf16x8*)(qsrc + r * BND_ROW + ks * 64 + kg * 16), kf = *(const LAS bf16x8*)(kd + r * BND_ROW + ks * 64 + kg * 16);
            if (ks & 1) At2 = MFMA16(kf, qf, At2); else At = MFMA16(kf, qf, At); }
        At = At + At2;
        if (wh != 1) {
#pragma unroll
            for (int j = 0; j < 4; ++j) if (4 * kg + j > r) At[j] = 0.f; }
        v2u ab; ab.x = cvtpk(At[0], At[1]); ab.y = cvtpk(At[2], At[3]);
        *(LAS v2u*)(im + BND_A2 + ((wh == 0 ? 0 : 16) + r) * 64 + ((((wh == 2 ? 2 : 0) + (kg >> 1)) ^ ((-(r >> 2)) & 3)) * 16) + (kg & 1) * 8) = ab;
    }
    __syncthreads();
    {
        unsigned char* dst = BND + ((size_t)bhx * NPAIR + grp * 2) * BND_BYTES;
#pragma unroll
        for (int i = 0; i < 2 * BND_BYTES / 16 / 512; ++i) { const int c = tid + 512 * i; *(GAS v4u*)(dst + c * 16) = *(const LAS v4u*)(lds + PRP_OUT + c * 16); }
    }
}

__device__ __forceinline__ void rec_unit(int u, const unsigned char* BND, const bf16* H, bf16* YCAT, LAS unsigned char* lds, int tid) {
    const int lane = tid & 63, wave = __builtin_amdgcn_readfirstlane(tid >> 6), r = lane & 15, kg = lane >> 4;
    const bool gla = u < 64;
    const int bh = gla ? (u >> 2) : ((u - 64) >> 1), dvg = gla ? (u & 3) : ((u - 64) & 1), bhx = gla ? bh : 16 + bh;
    const int b = gla ? (bh >> 2) : (bh >> 3), h = gla ? (bh & 3) : (bh & 7);
    const unsigned char* bnd = BND + (size_t)bhx * NPAIR * BND_BYTES;
    const bf16* vsrc = H + (size_t)b * SEQ * NH + (gla ? HC_GV + h * 256 : HC_HI + h * 128) + dvg * 64;
    const int ocol = (gla ? BW + h * 256 : 2 * BW + h * 128) + dvg * 64;
#define REC_BAR() do { asm volatile("" ::: "memory"); __builtin_amdgcn_s_barrier(); asm volatile("" ::: "memory"); } while (0)
    __syncthreads();
    if (wave >= 4) {
        const int lw = wave - 4;
        constexpr int RDEPTH = 4;
        const GAS unsigned char* gsrc[6]; int lofs[6]; size_t gstep[6];
#pragma unroll
        for (int q = 0; q < 6; ++q) { const int p = lw + 4 * q; lofs[q] = p * 1024 + lane * 16;
            gsrc[q] = (const GAS unsigned char*)(p < 20 ? bnd + p * 1024 + lane * 16 : (const unsigned char*)(vsrc + (size_t)(8 * (p - 20) + (lane >> 3)) * NH) + (lane & 7) * 16); gstep[q] = p < 20 ? (size_t)BND_BYTES : (size_t)32 * NH * 2; }
        v4u buf[RDEPTH][6];
#define REC_LOAD(j, pr_) do { const int pq = (pr_) < NPAIR ? (pr_) : NPAIR - 1; _Pragma("unroll") for (int q = 0; q < 6; ++q) { const GAS unsigned char* p_ = gsrc[q] + (size_t)pq * gstep[q]; \
            asm volatile("global_load_dwordx4 %0, %1, off" : "=v"(buf[j][q]) : "v"(p_) : "memory"); } } while (0)
#define REC_WRITE(j, pr_) do { asm volatile("s_waitcnt vmcnt(18)" : "+v"(buf[j][0]), "+v"(buf[j][1]), "+v"(buf[j][2]), "+v"(buf[j][3]), "+v"(buf[j][4]), "+v"(buf[j][5]) :: "memory"); \
            LAS unsigned char* slot = lds + ((pr_) % 3) * SLOT_BYTES; _Pragma("unroll") for (int q = 0; q < 6; ++q) *(LAS v4u*)(slot + lofs[q]) = buf[j][q]; } while (0)
#pragma unroll
        for (int j = 0; j < RDEPTH; ++j) REC_LOAD(j, j);
        REC_WRITE(0, 0); REC_LOAD(0, RDEPTH); REC_WRITE(1, 1); REC_LOAD(1, RDEPTH + 1);
        asm volatile("s_waitcnt lgkmcnt(0)" ::: "memory");
        REC_BAR();
        for (int n = 0; n < NPAIR; n += RDEPTH) {
#pragma unroll
            for (int j = 0; j < RDEPTH; ++j) { const int m = n + j;
                REC_WRITE((j + 2) % RDEPTH, m + 2); REC_LOAD((j + 2) % RDEPTH, m + 2 + RDEPTH);
                asm volatile("s_waitcnt lgkmcnt(0)" ::: "memory");
                REC_BAR(); }
        }
        asm volatile("s_waitcnt vmcnt(0)" : "+v"(buf[0][0]), "+v"(buf[0][1]), "+v"(buf[0][2]), "+v"(buf[0][3]), "+v"(buf[0][4]), "+v"(buf[0][5]), "+v"(buf[1][0]), "+v"(buf[1][1]), "+v"(buf[1][2]), "+v"(buf[1][3]), "+v"(buf[1][4]), "+v"(buf[1][5]),
                                            "+v"(buf[2][0]), "+v"(buf[2][1]), "+v"(buf[2][2]), "+v"(buf[2][3]), "+v"(buf[2][4]), "+v"(buf[2][5]), "+v"(buf[3][0]), "+v"(buf[3][1]), "+v"(buf[3][2]), "+v"(buf[3][3]), "+v"(buf[3][4]), "+v"(buf[3][5]) :: "memory");
#undef REC_LOAD
#undef REC_WRITE
    } else {
        f32x4 S[8]; const int ksw = kg ^ ((-(r >> 2)) & 3);
#pragma unroll
        for (int kt = 0; kt < 8; ++kt) S[kt] = (f32x4){0.f, 0.f, 0.f, 0.f};
        REC_BAR();
        for (int n = 0; n < NPAIR; ++n) {
            const LAS unsigned char* base = lds + (n % 3) * SLOT_BYTES;
            bf16x8 qf[2][4], af[2], kf[8]; f32x4 gl[8];
#pragma unroll
            for (int tt = 0; tt < 2; ++tt) {
#pragma unroll
                for (int ks = 0; ks < 4; ++ks) qf[tt][ks] = *(const LAS bf16x8*)(base + BND_Q2 + (16 * tt + r) * BND_ROW + ks * 64 + kg * 16);
                af[tt] = *(const LAS bf16x8*)(base + BND_A2 + (16 * tt + r) * 64 + ksw * 16); }
            unsigned vw[4];
            { const LAS bf16* vp = (const LAS bf16*)(base + SLOT_VT) + (8 * kg) * 64 + 16 * wave + r;
#pragma unroll
              for (int j = 0; j < 4; ++j) vw[j] = (unsigned)vp[(2 * j) * 64] | ((unsigned)vp[(2 * j + 1) * 64] << 16); }
            const bf16x8 vf = mk8(vw[0], vw[1], vw[2], vw[3]);
#pragma unroll
            for (int kt = 0; kt < 8; ++kt) { kf[kt] = *(const LAS bf16x8*)(base + BND_K2T + (16 * kt + r) * 64 + ksw * 16); gl[kt] = *(const LAS f32x4*)(base + BND_GL + (16 * kt + 4 * kg) * 4); }
            bf16x8 sf[4];
#pragma unroll
            for (int ks = 0; ks < 4; ++ks) { const f32x4 s0 = S[2 * ks], s1 = S[2 * ks + 1]; sf[ks] = mk8(cvtpk(s0[0], s0[1]), cvtpk(s0[2], s0[3]), cvtpk(s1[0], s1[1]), cvtpk(s1[2], s1[3])); }
            f32x4 o0 = MFMA16(vf, af[0], ((f32x4){0.f, 0.f, 0.f, 0.f})), o1 = MFMA16(vf, af[1], ((f32x4){0.f, 0.f, 0.f, 0.f}));
#pragma unroll
            for (int ks = 0; ks < 4; ++ks) { o0 = MFMA16(sf[ks], qf[0][ks], o0); o1 = MFMA16(sf[ks], qf[1][ks], o1); }
#pragma unroll
            for (int kt = 0; kt < 8; ++kt) S[kt] = MFMA16(kf[kt], vf, S[kt] * gl[kt]);
            { GAS bf16* op = (GAS bf16*)(YCAT + ((size_t)b * SEQ + (size_t)n * 32 + r) * (3 * BW) + ocol + 16 * wave + 4 * kg);
              v2u w; w.x = cvtpk(o0[0], o0[1]); w.y = cvtpk(o0[2], o0[3]); *(GAS v2u*)op = w;
              w.x = cvtpk(o1[0], o1[1]); w.y = cvtpk(o1[2], o1[3]); *(GAS v2u*)(op + (size_t)16 * (3 * BW)) = w; }
            asm volatile("s_waitcnt lgkmcnt(0)" ::: "memory");
            REC_BAR();
        }
    }
    __syncthreads();
#undef REC_BAR
}

__device__ __forceinline__ void post_rows(const Args& args, int l, const bf16* H, bf16* YCAT, int gw, int NGW, int lane) {
    const f32x4 nwg = *(const f32x4*)(args.in[I_GNW] + l * 256 + 4 * lane);
    for (int t0 = gw; t0 < M * 4; t0 += 4 * NGW) {
        v2u ov[4], gv[4]; GAS bf16* yp[4];
#pragma unroll
        for (int j = 0; j < 4; ++j) { const int t = t0 + j * NGW < M * 4 ? t0 + j * NGW : t0; const int row = t >> 2, hh = t & 3;
            yp[j] = (GAS bf16*)(YCAT + (size_t)row * (3 * BW) + BW + hh * 256 + 4 * lane);
            ov[j] = *(const GAS v2u*)yp[j]; gv[j] = *(const GAS v2u*)(H + (size_t)row * NH + HC_GG + hh * 256 + 4 * lane); }
#pragma unroll
        for (int j = 0; j < 4; ++j) {
            const float o0 = bflo(ov[j].x), o1 = bfhi(ov[j].x), o2 = bflo(ov[j].y), o3 = bfhi(ov[j].y);
            const float rstd = rsqrtf(wave_sum(o0 * o0 + o1 * o1 + o2 * o2 + o3 * o3) * (1.0f / 256.0f) + RMS_EPS);
            const float g0 = bflo(gv[j].x), g1 = bfhi(gv[j].x), g2 = bflo(gv[j].y), g3 = bfhi(gv[j].y);
            v2u w; w.x = cvtpk(o0 * rstd * nwg[0] * (g0 * sigm(g0)), o1 * rstd * nwg[1] * (g1 * sigm(g1))); w.y = cvtpk(o2 * rstd * nwg[2] * (g2 * sigm(g2)), o3 * rstd * nwg[3] * (g3 * sigm(g3)));
            if (t0 + j * NGW < M * 4) *(GAS v2u*)yp[j] = w; }
    }
    const f32x4 nwh = *(const f32x4*)(args.in[I_HNW] + l * 128 + 4 * (lane & 31));
    for (int t0 = gw; t0 < M * 4; t0 += 4 * NGW) {
        v2u ov[4], gv[4]; GAS bf16* yp[4];
#pragma unroll
        for (int j = 0; j < 4; ++j) { const int t = t0 + j * NGW < M * 4 ? t0 + j * NGW : t0; const int row = t >> 2, hp = t & 3;
            yp[j] = (GAS bf16*)(YCAT + (size_t)row * (3 * BW) + 2 * BW + hp * 256 + 4 * lane);
            ov[j] = *(const GAS v2u*)yp[j]; gv[j] = *(const GAS v2u*)(H + (size_t)row * NH + HC_HG + hp * 256 + 4 * lane); }
#pragma unroll
        for (int j = 0; j < 4; ++j) {
            const float o0 = bflo(ov[j].x) * sigm(bflo(gv[j].x)), o1 = bfhi(ov[j].x) * sigm(bfhi(gv[j].x)), o2 = bflo(ov[j].y) * sigm(bflo(gv[j].y)), o3 = bfhi(ov[j].y) * sigm(bfhi(gv[j].y));
            const float rstd = rsqrtf(half_sum((o0 * o0 + o1 * o1) + (o2 * o2 + o3 * o3), lane) * (1.0f / 128.0f) + RMS_EPS);
            v2u w; w.x = cvtpk(o0 * rstd * nwh[0], o1 * rstd * nwh[1]); w.y = cvtpk(o2 * rstd * nwh[2], o3 * rstd * nwh[3]);
            if (t0 + j * NGW < M * 4) *(GAS v2u*)yp[j] = w; }
    }
}

__global__ void __launch_bounds__(NWAVES * 64, 2) mega_fwd(Args args) {
    extern __shared__ __attribute__((aligned(16))) unsigned char lds_raw[];
    LAS unsigned char* lds = (LAS unsigned char*)lds_raw;
    volatile LAS unsigned* MISC = (volatile LAS unsigned*)(lds + MISC_OFF);
    const int G = gridDim.x, bid = blockIdx.x;
#define FRESH_IDS() int tid = threadIdx.x; asm volatile("" : "+v"(tid)); const int lane = tid & 63, wave = __builtin_amdgcn_readfirstlane(tid >> 6), gw = bid * NWAVES + wave, NGW = G * NWAVES; (void)lane; (void)gw; (void)NGW
    unsigned* ctl = (unsigned*)(args.ws + WS_CTL);
    for (int u = threadIdx.x; u < (LDS_BYTES - LDSCTL_OFF) / 4; u += NWAVES * 64) ((LAS unsigned*)(lds + LDSCTL_OFF))[u] = 0u;
    __syncthreads();
    const int lo = args.ph_lo, hi = args.ph_hi;
    const bool use_bar = (hi - lo) > 1;
    unsigned* barw = ctl + CW_BAR + args.bar_idx * XCD_BAR_WORDS;
    XcdBarrier bar; bar.bar = barw; bar.x = 0; bar.st = nullptr;
    if (use_bar) bar = xcd_barrier_post(barw, MISC + 8);
#ifndef PHMASK
#define PHMASK 0x3ff
#endif
#define IN(k) (((PHMASK >> ((k) % NPH)) & 1) && lo <= (k) && (k) < hi)
#define SEAM(k) do { if (lo <= (k) && (k) + 1 < hi) xcd_barrier(bar); } while (0)
#ifndef REP_PH
#define REP_PH -1
#endif
#ifndef REP_N
#define REP_N 1
#endif
#define RPT(k) for (int rep_ = 0; rep_ < ((k) == REP_PH ? 1 + REP_N : 1); ++rep_)

#define PTRS() unsigned char* ws = args.ws; asm volatile("" : "+s"(ws)); bf16* WinT = (bf16*)(ws + WS_WIN); bf16* WgluT = (bf16*)(ws + WS_WGLU); bf16* WupT = (bf16*)(ws + WS_WUP); bf16* WoutT = (bf16*)(ws + WS_WOUT); bf16* W1T = (bf16*)(ws + WS_W1); bf16* W2T = (bf16*)(ws + WS_W2); bf16* XB = (bf16*)(ws + WS_XB); bf16* Y = (bf16*)(ws + WS_Y); bf16* H = (bf16*)(ws + WS_H); bf16* HID = (bf16*)(ws + WS_H); bf16* Z = (bf16*)(ws + WS_Z); bf16* YCAT = (bf16*)(ws + WS_YCAT); bf16* MERGED = (bf16*)(ws + WS_MERGED); bf16* UU = (bf16*)(ws + WS_U); bf16* S5W = (bf16*)(ws + WS_S5W); bf16* S5TQ = (bf16*)(ws + WS_S5TQ); float* S5C = (float*)(ws + WS_S5C); bf16* WglowT = (bf16*)(ws + WS_WGLOW); float* GLOW = (float*)(ws + WS_GLOW); unsigned char* BND = ws + WS_BND; bf16* VT = (bf16*)(ws + WS_VT); bf16* Y2 = (bf16*)(ws + WS_Y2); float* ST1 = (float*)(ws + WS_ST); float* ST2 = ST1 + 2 * M; float* ST0 = (float*)(ws + WS_ID); (void)WinT; (void)WgluT; (void)WupT; (void)WoutT; (void)W1T; (void)W2T; (void)XB; (void)Y; (void)H; (void)HID; (void)Z; (void)YCAT; (void)MERGED; (void)UU; (void)S5W; (void)S5TQ; (void)S5C; (void)WglowT; (void)GLOW; (void)BND; (void)VT; (void)Y2; (void)ST1; (void)ST2; (void)ST0;

    for (int l = 0; l < DEPTH; ++l) {
        const int P = l * NPH;
        RPT(0) if (IN(P + 0)) {
            PTRS(); FRESH_IDS();
            if (l > 0) ln_phase(Y2, args.in[I_LN2G] + (size_t)(l - 1) * D, args.in[I_LN2B] + (size_t)(l - 1) * D, nullptr, XB, ST2, gw, NGW, lane);
            if (l == 0) for (int lg = bid; lg < DEPTH * 64; lg += G) s5_build(args, lg >> 6, lg & 63, S5W + (size_t)lg * 128 * 256, S5TQ + (size_t)lg * 256 * 384, S5C + (size_t)lg * 256, lds, tid);
            __syncthreads();
            LAS float* scr = (LAS float*)(lds + wave * 16384);
            const float* w_in = args.in[I_WIN] + (size_t)l * D * IN_TOTAL;
            const float* w_glu = args.in[I_WGLU] + (size_t)l * BW * BW;
            const float* w_up = args.in[I_WUP] + (size_t)l * 3 * BW * D;
            const float* w_out = args.in[I_WOUT] + (size_t)l * D * D;
            const float* w1 = args.in[I_W1] + (size_t)l * D * FF;
            const float* w2 = args.in[I_W2] + (size_t)l * FF * D;
            constexpr int I_A = (D / 64) * (3072 / 32), I_B = (D / 64) * ((NH - 3072) / 32), I_G = (BW / 64) * (BW / 32), I_U = (BW / 64) * (D / 32), I_O = (D / 64) * (D / 32), I_1 = (D / 64) * (FF / 32), I_2 = (FF / 64) * (D / 32), I_L = D / 64;
            constexpr int NITEMS = I_A + I_B + I_G + 3 * I_U + I_O + I_1 + I_2 + I_L;
            for (int it = gw; it < NITEMS; it += NGW) {
                int r = it;
                if (r < I_A) { cvt_item(w_in, IN_TOTAL, 0, WinT, D, 0, 0, 3072 / 32, r, scr, lane); continue; } r -= I_A;
                if (r < I_B) { cvt_item(w_in, IN_TOTAL, 3072 + 16, WinT, D, 3072, 0, (NH - 3072) / 32, r, scr, lane); continue; } r -= I_B;
                if (r < I_G) { cvt_item(w_glu, BW, 0, WgluT, BW, 0, 0, BW / 32, r, scr, lane); continue; } r -= I_G;
                if (r < 3 * I_U) { const int b = r / I_U; cvt_item(w_up + (size_t)b * BW * D, D, 0, WupT, 3 * BW, 0, b * BW, D / 32, r - b * I_U, scr, lane); continue; } r -= 3 * I_U;
                if (r < I_O) { cvt_item(w_out, D, 0, WoutT, D, 0, 0, D / 32, r, scr, lane); continue; } r -= I_O;
                if (r < I_1) { cvt_item(w1, FF, 0, W1T, D, 0, 0, FF / 32, r, scr, lane); continue; } r -= I_1;
                if (r < I_2) { cvt_item(w2, D, 0, W2T, FF, 0, 0, D / 32, r, scr, lane); continue; } r -= I_2;
                cvt_item(w_in, IN_TOTAL, GLOW_COL, WglowT, D, 0, 0, 1, r, scr, lane);
            }
            if (l == 0) {
                for (int i = bid * 512 + tid; i < 2 * M + 2 * D + DEPTH * 4 * D; i += G * 512) {
                    float v;
                    if (i < 2 * M) v = (float)(i & 1); else if (i < 2 * M + D) v = 1.0f; else if (i < 2 * M + 2 * D) v = 0.0f;
                    else { const int e = i - 2 * M - 2 * D, ll = e / (4 * D), w = (e / D) & 3, c = e % D; const float a0 = args.in[I_LN1G][ll * D + c], a1 = args.in[I_LN1B][ll * D + c], a2 = args.in[I_LN2G][ll * D + c], a3 = args.in[I_LN2B][ll * D + c];
                           v = w == 0 ? a0 : w == 1 ? a1 : w == 2 ? a2 : a3; }
                    ST0[i] = v; }
                const f32x4* xs = (const f32x4*)args.in[I_X]; unsigned long long* xd = (unsigned long long*)XB;
                unsigned long long* xh = (unsigned long long*)Y2;
                for (size_t i = (size_t)bid * 512 + tid; i < (size_t)M * D / 4; i += (size_t)G * 512) { const f32x4 v = xs[i]; xd[i] = (unsigned long long)pk2(v[0], v[1]) | ((unsigned long long)pk2(v[2], v[3]) << 32); xh[i] = (unsigned long long)cvtpk_h(v[0], v[1]) | ((unsigned long long)cvtpk_h(v[2], v[3]) << 32); }
            }
        }
        SEAM(P + 0);
        RPT(1) if (IN(P + 1)) {
            PTRS();
            { pg8::Gemm g{XB, WinT, M, NH, D}; pg8::StaticOrder S; S.init(M, NH, G, bid);
              pg8::EpiH E{H, NH, UU};
              pg8::gemm_phase<pg8::EpiH, pg8::StaticOrder, true, true>(lds, g, S, E); }
            FRESH_IDS();
            if (wave < 4) for (int gq = bid; gq < M / 64; gq += G) glow_tile(XB, WglowT, GLOW, gq * 64 + 16 * wave, lane);
        }
        SEAM(P + 1);
        RPT(2) if (IN(P + 2)) {
            PTRS(); FRESH_IDS();
            if (bid < 48 * 64) prep_dma(bid, 0, H, GLOW, lds, tid);
            { int p = 0; for (int u = bid; u < 48 * 64; u += G, p ^= 1) prep_unit(args, l, u, u + G, p, H, GLOW, BND, lds, tid); }
            __syncthreads();
        }
        SEAM(P + 2);
        RPT(3) if (IN(P + 3)) {
            PTRS(); FRESH_IDS();
            const int nrec = G >= 256 ? 128 : G / 2;
#ifndef REP_REC
#define REP_REC 0
#endif
            if (bid < nrec) { for (int rr_ = 0; rr_ <= REP_REC; ++rr_) for (int v = bid; v < 128; v += nrec) {
                    const int x = v & 7, sl = v >> 3; const int u = sl < 8 ? (2 * x + (sl >> 2)) * 4 + (sl & 3) : 64 + (4 * x + ((sl - 8) >> 1)) * 2 + ((sl - 8) & 1);
                    rec_unit(u, BND, H, YCAT, lds, tid); } }
#ifndef REP_S5
#define REP_S5 0
#endif
            else { for (int rs_ = 0; rs_ <= REP_S5; ++rs_) for (int u = bid - nrec; u < 256; u += G - nrec) { const int b = u >> 6, g = u & 63;
                    s5_unit(UU + (size_t)(b * 64 + g) * SEQ * 16, S5W + (size_t)(l * 64 + g) * 128 * 256, S5TQ + (size_t)(l * 64 + g) * 256 * 384, S5C + (size_t)(l * 64 + g) * 256, args.in[I_S5D] + l * BW + g * 16, Z + (size_t)b * SEQ * BW + g * 16, lds, tid); } }
        }
        SEAM(P + 3);
        RPT(4) if (IN(P + 4)) {
            PTRS();
            { pg8::Gemm g{Z, WgluT, M, BW, BW}; pg8::StaticOrder S; S.init(M, BW, G, bid, 2);
              pg8::EpiGlu E{YCAT, 3 * BW, Z, BW, args.in[I_BGLU] + (size_t)l * BW};
              pg8::gemm_phase<pg8::EpiGlu, pg8::StaticOrder, true, true>(lds, g, S, E); }
            FRESH_IDS();
            post_rows(args, l, H, YCAT, gw, NGW, lane);
        }
        SEAM(P + 4);
        RPT(5) if (IN(P + 5)) {
            PTRS();
            pg8::Gemm g{YCAT, WupT, M, D, 3 * BW}; pg8::StaticOrder S; S.init(M, D, G, bid, 2);
            pg8::EpiMergeK E{MERGED, D, H + HC_MG, NH, D};
            pg8::gemm_phase<pg8::EpiMergeK, pg8::StaticOrder, true, true>(lds, g, S, E);
        }
        SEAM(P + 5);
        RPT(6) if (IN(P + 6)) {
            PTRS();
            pg8::Gemm g{MERGED, WoutT, M, D, D}; pg8::StaticOrder S; S.init(M, D, G, bid, 2);
            pg8::EpiRes E{Y, Y2, l == 0 ? ST0 : ST2, ST0 + 2 * M + (l == 0 ? 0 : 2 * D + (l - 1) * 4 * D + 2 * D)};
            pg8::gemm_phase<pg8::EpiRes, pg8::StaticOrder, true, true>(lds, g, S, E);
        }
        SEAM(P + 6);
        RPT(7) if (IN(P + 7)) { PTRS(); FRESH_IDS(); ln_phase(Y, args.in[I_LN1G] + (size_t)l * D, args.in[I_LN1B] + (size_t)l * D, nullptr, XB, ST1, gw, NGW, lane); }
        SEAM(P + 7);
        RPT(8) if (IN(P + 8)) {
            PTRS();
            pg8::Gemm g{XB, W1T, M, FF, D}; pg8::StaticOrder S; S.init(M, FF, G, bid);
            pg8::EpiRelu2 E{HID, FF};
            pg8::gemm_phase<pg8::EpiRelu2, pg8::StaticOrder, true, true>(lds, g, S, E);
        }
        SEAM(P + 8);
        RPT(9) if (IN(P + 9)) {
            PTRS();
            pg8::Gemm g{HID, W2T, M, D, FF}; pg8::StaticOrder S; S.init(M, D, G, bid, 2);
            pg8::EpiRes E{Y2, Y, ST1, ST0 + 2 * M + 2 * D + l * 4 * D};
            pg8::gemm_phase<pg8::EpiRes, pg8::StaticOrder, true, true>(lds, g, S, E);
        }
        SEAM(P + 9);
    }
    if (IN(DEPTH * NPH)) { PTRS(); FRESH_IDS(); ln_phase(Y2, args.in[I_LN2G] + (size_t)(DEPTH - 1) * D, args.in[I_LN2B] + (size_t)(DEPTH - 1) * D, args.out, XB, ST2, gw, NGW, lane); }
#undef IN
#undef SEAM
}

#ifndef N_SPLIT
#define N_SPLIT 1
#endif
extern "C" void kernel_launch(void* const* d_in, const int* in_sizes, int n_in, void* d_out, int out_size, void* d_ws, size_t ws_size, hipStream_t stream) {
    static int grid = 0;
    if (grid == 0) {
        if (n_in != 25 || out_size != M * D || ws_size < WS_END) { fprintf(stderr, "kernel_launch: unexpected shapes (n_in %d out %d ws %zu need %zu)\n", n_in, out_size, ws_size, (size_t)WS_END); grid = -1; return; }
        int dev = 0, cus = 0;
        if (hipGetDevice(&dev) != hipSuccess || hipDeviceGetAttribute(&cus, hipDeviceAttributeMultiprocessorCount, dev) != hipSuccess) { grid = -1; return; }
        if (hipFuncSetAttribute((const void*)mega_fwd, hipFuncAttributeMaxDynamicSharedMemorySize, LDS_BYTES) != hipSuccess) { fprintf(stderr, "kernel_launch: hipFuncSetAttribute failed\n"); grid = -1; return; }
        int per_cu = 0;
        (void)hipOccupancyMaxActiveBlocksPerMultiprocessor(&per_cu, (const void*)mega_fwd, NWAVES * 64, LDS_BYTES);
        (void)hipGetLastError();
        grid = cus;
    }
    if (grid < 0) return;
    (void)hipMemsetAsync((char*)d_ws + WS_CTL, 0, CTL_ZERO_BYTES, stream);
    Args a{};
    for (int i = 0; i < 25; ++i) a.in[i] = (const float*)d_in[i];
    a.out = (float*)d_out; a.ws = (unsigned char*)d_ws;
#if N_SPLIT == 1
    a.ph_lo = 0; a.ph_hi = DEPTH * NPH + 1; a.bar_idx = 0;
    hipLaunchKernelGGL(mega_fwd, dim3(grid), dim3(NWAVES * 64), LDS_BYTES, stream, a);
#else
    for (int p = 0; p < DEPTH * NPH + 1; ++p) { a.ph_lo = p; a.ph_hi = p + 1; a.bar_idx = 0; hipLaunchKernelGGL(mega_fwd, dim3(grid), dim3(NWAVES * 64), LDS_BYTES, stream, a);
    }
#endif
}
```
